# Optimizing an MI355X kernel written in HIP

```python
import jax, jax.numpy as jnp
from jax import lax
import numpy as np

D_MODEL = 1024
BATCH = 8
SEQ = 2048
DEPTH = 4

N_MIXERS = 3
N_A_LAYERS = (DEPTH + 2) // 3
N_B_LAYERS = (DEPTH + 1) // 3
N_C_LAYERS = DEPTH // 3
NORM_EPS = 1e-6
NEG_BIG = -1e30
LB_FLOOR = 1e-30

A_WIDTH = D_MODEL
A_HEAD_DIM = 128
A_HEADS = A_WIDTH // A_HEAD_DIM
A_CHUNK = 64

B_HEAD_DIM = 64
B_HEADS = D_MODEL // B_HEAD_DIM
B_WIDTH = B_HEADS * B_HEAD_DIM
DILATED_GROUPS = ((128, 1), (512, 4), (2048, 16))
B_N_GROUPS = len(DILATED_GROUPS)
ALIBI_MAX_EXP = 8.0

C_WIDTH = D_MODEL
C_CHUNK = 128
C_GROUPS = 8
C_GROUP_DIM = C_WIDTH // C_GROUPS

kernel_name = 'hybrid_hgrn2_dilated_gmlp'


def rms_norm(x, w):
    xf = x.astype(jnp.float32)
    y = xf * lax.rsqrt(jnp.mean(xf * xf, axis=-1, keepdims=True) + NORM_EPS)
    return (y * w.astype(jnp.float32)).astype(x.dtype)


def layer_norm(x, w, b):
    xf = x.astype(jnp.float32)
    mu = jnp.mean(xf, axis=-1, keepdims=True)
    xc = xf - mu
    y = xc * lax.rsqrt(jnp.mean(xc * xc, axis=-1, keepdims=True) + NORM_EPS)
    return (y * w.astype(jnp.float32) + b.astype(jnp.float32)).astype(x.dtype)


def hgrn2_mixer(h, w_in, lower_bound, o_norm_w, w_out):
    bsz, seq, _ = h.shape
    n_chunks = seq // A_CHUNK
    q, f, inp_v, g = jnp.split(h @ w_in, 4, axis=-1)
    f32 = jnp.float32
    q = jax.nn.silu(q.astype(f32))
    f = f.astype(f32)
    lb = lower_bound.astype(f32)
    k = (1.0 - lb) * jax.nn.sigmoid(-f)
    log_f = jnp.logaddexp(jnp.log(jnp.maximum(lb, LB_FLOOR)),
                          jnp.log1p(-lb) + jax.nn.log_sigmoid(f))

    def heads(t):
        return t.reshape(bsz, n_chunks, A_CHUNK, A_HEADS, A_HEAD_DIM).transpose(1, 0, 3, 2, 4)

    xs = (heads(q), heads(k), heads(inp_v.astype(f32)), heads(log_f))
    causal = jnp.tril(jnp.ones((A_CHUNK, A_CHUNK), dtype=bool))

    def chunk_step(state, inp):
        qc, kc, vc, lc = inp
        b = jnp.cumsum(lc, axis=-2)
        diff = b[..., :, None, :] - b[..., None, :, :]
        decay = jnp.exp(jnp.where(causal[:, :, None], diff, NEG_BIG))
        scores = jnp.einsum('bhtk,bhsk,bhtsk->bhts', qc, kc, decay)
        o = scores @ vc + jnp.einsum('bhtk,bhkv->bhtv', qc * jnp.exp(b), state)
        b_last = b[..., -1:, :]
        state = (jnp.exp(b_last[..., 0, :])[..., None] * state
                 + jnp.einsum('bhsk,bhsv->bhkv', kc * jnp.exp(b_last - b), vc))
        return state, o

    state0 = jnp.zeros((bsz, A_HEADS, A_HEAD_DIM, A_HEAD_DIM), f32)
    _, o = lax.scan(chunk_step, state0, xs)
    o = o.transpose(1, 0, 3, 2, 4).reshape(bsz, seq, A_HEADS, A_HEAD_DIM)
    o = rms_norm(o, o_norm_w).reshape(bsz, seq, A_WIDTH)
    y = (o * jax.nn.silu(g.astype(f32))).astype(h.dtype)
    return y @ w_out


def dilated_window_attention(q, k, v, window, dilation, slopes):
    bsz, nh, seq, hd = q.shape
    n_keys = window // dilation
    sub_len = seq // dilation
    n_blk = -(-sub_len // n_keys)
    pad = n_blk * n_keys - sub_len

    def to_blocks(t):
        t = t.reshape(bsz, nh, sub_len, dilation, hd).transpose(0, 1, 3, 2, 4)
        t = jnp.pad(t, ((0, 0), (0, 0), (0, 0), (0, pad), (0, 0)))
        return t.reshape(bsz, nh, dilation, n_blk, n_keys, hd)

    def with_prev(t):
        prev = jnp.pad(t, ((0, 0), (0, 0), (0, 0), (1, 0), (0, 0), (0, 0)))[:, :, :, :-1]
        return jnp.concatenate([prev, t], axis=-2)

    qb = to_blocks(q)
    kb = with_prev(to_blocks(k))
    vb = with_prev(to_blocks(v))
    scores = jnp.einsum('bhrnid,bhrnjd->bhrnij', qb, kb).astype(jnp.float32) * (hd ** -0.5)
    qi = jnp.arange(n_keys)[:, None]
    kj = jnp.arange(2 * n_keys)[None, :]
    dist = n_keys + qi - kj
    key_idx = (jnp.arange(n_blk)[:, None, None] - 1) * n_keys + kj
    valid = (dist >= 0) & (dist <= n_keys) & (key_idx >= 0)
    alibi = -slopes.astype(jnp.float32)[:, None, None, None, None] * (dist * dilation).astype(jnp.float32)
    scores = jnp.where(valid, scores + alibi, NEG_BIG)
    lse = jax.nn.logsumexp(scores, axis=-1)
    p = jnp.exp(scores - lse[..., None])
    o = jnp.einsum('bhrnij,bhrnjd->bhrnid', p.astype(v.dtype), vb)
    o = o.reshape(bsz, nh, dilation, n_blk * n_keys, hd)[:, :, :, :sub_len]
    o = o.transpose(0, 1, 3, 2, 4).reshape(bsz, nh, seq, hd)
    lse = lse.reshape(bsz, nh, dilation, n_blk * n_keys)[..., :sub_len]
    lse = lse.transpose(0, 1, 3, 2).reshape(bsz, nh, seq)
    return o, lse


def dilated_attention_mixer(h, w_in, q_norm_w, k_norm_w, w_out):
    bsz, seq, _ = h.shape
    proj = h @ w_in
    n_qkv = 3 * B_N_GROUPS * B_WIDTH
    qkv = proj[..., :n_qkv].reshape(bsz, seq, B_N_GROUPS, 3, B_HEADS, B_HEAD_DIM)
    g = proj[..., n_qkv:]
    n_total = B_N_GROUPS * B_HEADS
    slopes = jnp.exp2(-ALIBI_MAX_EXP * jnp.arange(1, n_total + 1, dtype=jnp.float32) / n_total)
    slopes = slopes.reshape(B_N_GROUPS, B_HEADS)
    outs, lses = [], []
    for gi, (window, dilation) in enumerate(DILATED_GROUPS):
        q = rms_norm(qkv[:, :, gi, 0], q_norm_w[gi]).transpose(0, 2, 1, 3)
        k = rms_norm(qkv[:, :, gi, 1], k_norm_w[gi]).transpose(0, 2, 1, 3)
        v = qkv[:, :, gi, 2].transpose(0, 2, 1, 3)
        o, lse = dilated_window_attention(q, k, v, window, dilation, slopes[gi])
        outs.append(o)
        lses.append(lse)
    weights = jax.nn.softmax(jnp.stack(lses), axis=0)
    o = jnp.einsum('gbhs,gbhsd->bshd', weights.astype(outs[0].dtype), jnp.stack(outs))
    o = o.reshape(bsz, seq, B_WIDTH)
    y = (o.astype(jnp.float32) * jax.nn.silu(g.astype(jnp.float32))).astype(h.dtype)
    return y @ w_out


def spatial_gating_mixer(h, w_in, v_norm_w, v_norm_b, w_s, b_s, w_out):
    bsz, seq, _ = h.shape
    u, v, g = jnp.split(h @ w_in, 3, axis=-1)
    u = jax.nn.gelu(u)
    v = layer_norm(jax.nn.gelu(v), v_norm_w, v_norm_b)
    v = v.reshape(bsz, seq // C_CHUNK, C_CHUNK, C_GROUPS, C_GROUP_DIM)
    w_causal = w_s * jnp.tril(jnp.ones((C_CHUNK, C_CHUNK), dtype=w_s.dtype))
    s = jnp.einsum('gts,bnsgc->bntgc', w_causal, v) + b_s.T[None, None, :, :, None]
    y = u * s.reshape(bsz, seq, C_WIDTH) * jax.nn.silu(g)
    return y @ w_out


def setup_inputs(seed: int = 0) -> dict:
    key = jax.random.key(seed)
    ks = jax.random.split(key, 16)
    nrm = jax.random.normal
    f32 = jnp.float32
    return {
        'x': nrm(ks[0], (BATCH, SEQ, D_MODEL), f32),
        'norm_w': 1.0 + 0.02 * nrm(ks[1], (DEPTH, D_MODEL), f32),
        'a_w_in': nrm(ks[2], (N_A_LAYERS, D_MODEL, 4 * A_WIDTH), f32) * D_MODEL ** -0.5,
        'a_lower_bounds': 0.1 * nrm(ks[3], (N_A_LAYERS, A_WIDTH), f32),
        'a_o_norm_w': 1.0 + 0.02 * nrm(ks[4], (N_A_LAYERS, A_HEAD_DIM), f32),
        'a_w_out': nrm(ks[5], (N_A_LAYERS, A_WIDTH, D_MODEL), f32) * A_WIDTH ** -0.5,
        'b_w_in': nrm(ks[6], (N_B_LAYERS, D_MODEL, (3 * B_N_GROUPS + 1) * B_WIDTH), f32) * D_MODEL ** -0.5,
        'b_q_norm_w': 1.0 + 0.02 * nrm(ks[7], (N_B_LAYERS, B_N_GROUPS, B_HEAD_DIM), f32),
        'b_k_norm_w': 1.0 + 0.02 * nrm(ks[8], (N_B_LAYERS, B_N_GROUPS, B_HEAD_DIM), f32),
        'b_w_out': nrm(ks[9], (N_B_LAYERS, B_WIDTH, D_MODEL), f32) * B_WIDTH ** -0.5,
        'c_w_in': nrm(ks[10], (N_C_LAYERS, D_MODEL, 3 * C_WIDTH), f32) * D_MODEL ** -0.5,
        'c_v_norm_w': 1.0 + 0.02 * nrm(ks[11], (N_C_LAYERS, C_WIDTH), f32),
        'c_v_norm_b': 0.02 * nrm(ks[12], (N_C_LAYERS, C_WIDTH), f32),
        'c_w_s': nrm(ks[13], (N_C_LAYERS, C_GROUPS, C_CHUNK, C_CHUNK), f32) * C_CHUNK ** -0.5,
        'c_b_s': 1.0 + 0.1 * nrm(ks[14], (N_C_LAYERS, C_GROUPS, C_CHUNK), f32),
        'c_w_out': nrm(ks[15], (N_C_LAYERS, C_WIDTH, D_MODEL), f32) * C_WIDTH ** -0.5,
    }


def reference(x, norm_w, a_w_in, a_lower_bounds, a_o_norm_w, a_w_out,
              b_w_in, b_q_norm_w, b_k_norm_w, b_w_out,
              c_w_in, c_v_norm_w, c_v_norm_b, c_w_s, c_b_s, c_w_out):
    lb_soft = jax.nn.softmax(a_lower_bounds.astype(jnp.float32), axis=0)
    lower_bounds = jnp.cumsum(lb_soft, axis=0) - lb_soft[0]
    for layer in range(DEPTH):
        h = rms_norm(x, norm_w[layer])
        kind, idx = layer % N_MIXERS, layer // N_MIXERS
        if kind == 0:
            y = hgrn2_mixer(h, a_w_in[idx], lower_bounds[idx], a_o_norm_w[idx], a_w_out[idx])
        elif kind == 1:
            y = dilated_attention_mixer(h, b_w_in[idx], b_q_norm_w[idx], b_k_norm_w[idx], b_w_out[idx])
        else:
            y = spatial_gating_mixer(h, c_w_in[idx], c_v_norm_w[idx], c_v_norm_b[idx],
                                     c_w_s[idx], c_b_s[idx], c_w_out[idx])
        x = x + y.astype(x.dtype)
    return x
```

```cpp
#include <hip/hip_runtime.h>
#include <hip/hip_cooperative_groups.h>
#include <cstdio>
#include <cstdint>
namespace cg = cooperative_groups;
namespace pg8 {
#define PG8_LAS __attribute__((address_space(3)))
typedef unsigned short bf16_t;
typedef short bf16x8 __attribute__((ext_vector_type(8)));
typedef float f32x4 __attribute__((ext_vector_type(4)));
typedef unsigned u32x4 __attribute__((ext_vector_type(4)));
constexpr int BM = 256, BK = 64, HALF = 128, HTB = HALF * BK * 2  , STAGE_BYTES = 8 * HTB, NXCD = 8, WGM = 8;

__host__ __device__ __forceinline__ int lds_byte(int r, int c) { const int st = (r >> 4) * 2 + (c >> 5), rr = r & 15, cc = c & 31, ob = rr * 64 + cc * 2; return st * 1024 + (ob ^ (((ob >> 9) & 1) << 5)); }
__host__ __device__ __forceinline__ void stage_rc(int b, int& R, int& C) { const int st = b / 1024, sb = b % 1024, swz = sb ^ (((sb >> 9) & 1) << 5); R = (st >> 1) * 16 + swz / 64; C = (st & 1) * 32 + (swz % 64) / 2; }
__host__ __device__ __forceinline__ int perm32(int rho) { const int n = rho >> 4, i = rho & 15; return 8 * (i >> 2) + 4 * n + (i & 3); }

struct Unit { int pm, pn; };
struct Gemm { const bf16_t* A; const bf16_t* Bt; int M, N, K; };

struct StaticOrder {
    int nM, nN, nwg, G, c;
    __host__ __device__ void init(int M, int N, int G_, int c_) { nM = M / BM; nN = N / BM; nwg = nM * nN; G = G_; c = c_; }
    __host__ __device__ bool next(int i, Unit& u) const {
        const long L = (long)i * G + c; if (L >= nwg) return false;
        int wgid = (int)L; { const int q = nwg / NXCD, r = nwg % NXCD, xcd = wgid % NXCD, off = wgid / NXCD; wgid = (xcd < r ? xcd * (q + 1) : r * (q + 1) + (xcd - r) * q) + off; }
        const int nig = WGM * nN, gid = wgid / nig, fm = gid * WGM, gsz = (nM - fm) < WGM ? (nM - fm) : WGM;
        u.pm = fm + ((wgid % nig) % gsz); u.pn = (wgid % nig) / gsz; return true;
    }
    __device__ __forceinline__ void a_ready(const Unit&) const {}
    __device__ __forceinline__ void done(const Unit&) const {}
};

__device__ __forceinline__ unsigned cvt_pk_bf16(float lo, float hi) { unsigned r; asm volatile("v_cvt_pk_bf16_f32 %0, %1, %2" : "=v"(r) : "v"(lo), "v"(hi)); return r; }
template <class Epi, class Sched, bool ALIGN_EPI = false, bool SP2 = false>
__device__ __forceinline__ void gemm_phase(PG8_LAS unsigned char* lds, const Gemm g, const Sched& S, const Epi& E) {
    int tid_l = threadIdx.x; asm volatile("" : "+v"(tid_l));
    const int tid = tid_l, wid = __builtin_amdgcn_readfirstlane(tid >> 6), lane = tid & 63, wr = wid >> 2, wc = wid & 3, fr = lane & 15, fq = lane >> 4;
    const int K = g.K, nt = K / BK;
    unsigned voffA[2], voffB[2];
#pragma unroll
    for (int i = 0; i < 2; ++i) { int R, C; stage_rc(tid * 16 + i * 8192, R, C); const int Rb = Epi::PERM ? ((R & ~31) + perm32(R & 31)) : R;
        voffA[i] = (unsigned)(R * K + C) * 2u; voffB[i] = (unsigned)(Rb * K + C) * 2u; }
    const size_t kstep = (size_t)(BK * 2);
    const size_t hstep = (size_t)HALF * K * 2;
    const size_t tstep = 2 * hstep;
    const unsigned ldsw = (unsigned)wid * 1024u;
    const int aoff = lds_byte(wr * 64 + fr, fq * 8), boff = lds_byte(wc * 32 + fr, fq * 8);
#define PG8_SA(b, h) (((b) * 2 + (h)) * HTB)
#define PG8_SB(b, h) ((4 + (b) * 2 + (h)) * HTB)
#define PG8_STAGE(bufoff, gbase, voff) do { _Pragma("unroll") for (int _i = 0; _i < 2; ++_i) \
        __builtin_amdgcn_global_load_lds((const unsigned*)((const char*)(gbase) + (voff)[_i]), (PG8_LAS unsigned*)(lds + (bufoff) + ldsw + _i * 8192), 16, 0, 0); } while (0)
#define PG8_LDA(dst, b, h) do { _Pragma("unroll") for (int m = 0; m < 4; ++m) _Pragma("unroll") for (int k = 0; k < 2; ++k) dst[m][k] = *(const PG8_LAS bf16x8*)(lds + PG8_SA(b, h) + aoff + m * 2048 + k * 1024); } while (0)
#define PG8_LDB(dst, b, h) do { _Pragma("unroll") for (int n = 0; n < 2; ++n) _Pragma("unroll") for (int k = 0; k < 2; ++k) dst[n][k] = *(const PG8_LAS bf16x8*)(lds + PG8_SB(b, h) + boff + n * 2048 + k * 1024); } while (0)
#define PG8_MMA(ai, bj, At, Bt) do { __builtin_amdgcn_s_setprio(1); _Pragma("unroll") for (int m = 0; m < 4; ++m) _Pragma("unroll") for (int n = 0; n < 2; ++n) _Pragma("unroll") for (int k = 0; k < 2; ++k) \
        acc[ai][bj][m][n] = __builtin_amdgcn_mfma_f32_16x16x32_bf16(Bt[n][k], At[m][k], acc[ai][bj][m][n], 0, 0, 0); __builtin_amdgcn_s_setprio(0); } while (0)
#define PG8_WAIT_V(n) asm volatile("s_waitcnt vmcnt(" #n ")" ::: "memory")
#define PG8_WAIT_L(n) asm volatile("s_waitcnt lgkmcnt(" #n ")" ::: "memory")
#define PG8_BAR __builtin_amdgcn_s_barrier()
#define PG8_SCHED __builtin_amdgcn_sched_barrier(0)
    Unit cur, nxt; int ui = 0;
    if (!S.next(0, cur)) return;
    f32x4 acc[2][2][4][2];
#pragma unroll
    for (int a = 0; a < 2; ++a)
#pragma unroll
        for (int b = 0; b < 2; ++b)
#pragma unroll
            for (int m = 0; m < 4; ++m)
#pragma unroll
                for (int n = 0; n < 2; ++n) acc[a][b][m][n] = (f32x4){0.f, 0.f, 0.f, 0.f};
    bf16x8 At[4][2], B0[2][2], B1[2][2];
    const char* cA = (const char*)g.A + (size_t)cur.pm * tstep; const char* cB = (const char*)g.Bt + (size_t)cur.pn * tstep;
    S.a_ready(cur);
    if constexpr (SP2) {
        PG8_STAGE(PG8_SB(0, 0), cB, voffB); PG8_STAGE(PG8_SB(0, 1), cB + hstep, voffB); PG8_STAGE(PG8_SA(0, 0), cA, voffA); PG8_STAGE(PG8_SA(0, 1), cA + hstep, voffA);
        if (wr == 1) PG8_BAR;
        PG8_WAIT_V(2); PG8_BAR;
        PG8_STAGE(PG8_SB(1, 0), cB + kstep, voffB); PG8_STAGE(PG8_SA(1, 0), cA + kstep, voffA); PG8_STAGE(PG8_SB(1, 1), cB + hstep + kstep, voffB);
        PG8_WAIT_V(6); PG8_BAR;
    } else {
        PG8_STAGE(PG8_SB(0, 0), cB, voffB); PG8_STAGE(PG8_SA(0, 0), cA, voffA); PG8_STAGE(PG8_SB(0, 1), cB + hstep, voffB); PG8_STAGE(PG8_SA(0, 1), cA + hstep, voffA);
        if (wr == 1) PG8_BAR;
        PG8_WAIT_V(4); PG8_BAR;
        PG8_STAGE(PG8_SB(1, 0), cB + kstep, voffB); PG8_STAGE(PG8_SA(1, 0), cA + kstep, voffA); PG8_STAGE(PG8_SB(1, 1), cB + hstep + kstep, voffB);
        PG8_WAIT_V(6); PG8_BAR;
    }
    for (;;) {
        const bool has_next = S.next(ui + 1, nxt);
        const char* nA = has_next ? (const char*)g.A + (size_t)nxt.pm * tstep : cA; const char* nB = has_next ? (const char*)g.Bt + (size_t)nxt.pn * tstep : cB;
        for (int t = 0; t < nt; t += 2) {
            const bool last = (t == nt - 2);
            const char* a1 = cA + (size_t)(t + 1) * kstep;
            const char* a2 = last ? nA : cA + (size_t)(t + 2) * kstep; const char* b2 = last ? nB : cB + (size_t)(t + 2) * kstep;
            const char* a3 = a2 + kstep; const char* b3 = b2 + kstep;
            if (last && has_next) S.a_ready(nxt);
            if constexpr (SP2) {
            PG8_LDB(B0, 0, 0); PG8_LDB(B1, 0, 1); PG8_SCHED; PG8_LDA(At, 0, 0); PG8_STAGE(PG8_SA(1, 1), a1 + hstep, voffA);
            PG8_WAIT_V(8); PG8_WAIT_L(0); PG8_BAR; PG8_MMA(0, 0, At, B0); PG8_MMA(0, 1, At, B1); PG8_BAR; PG8_SCHED;
            PG8_LDA(At, 0, 1); PG8_STAGE(PG8_SB(0, 0), b2, voffB); PG8_STAGE(PG8_SB(0, 1), b2 + hstep, voffB); PG8_STAGE(PG8_SA(0, 0), a2, voffA);
            PG8_WAIT_V(8); PG8_WAIT_L(0); PG8_BAR; PG8_MMA(1, 0, At, B0); PG8_MMA(1, 1, At, B1); PG8_BAR; PG8_SCHED;
            PG8_LDB(B0, 1, 0); PG8_LDB(B1, 1, 1); PG8_SCHED; PG8_LDA(At, 1, 0); PG8_STAGE(PG8_SA(0, 1), a2 + hstep, voffA);
            PG8_WAIT_V(8); PG8_WAIT_L(0); PG8_BAR; PG8_MMA(0, 0, At, B0); PG8_MMA(0, 1, At, B1); PG8_BAR; PG8_SCHED;
            PG8_LDA(At, 1, 1); PG8_STAGE(PG8_SB(1, 0), b3, voffB); PG8_STAGE(PG8_SB(1, 1), b3 + hstep, voffB); PG8_STAGE(PG8_SA(1, 0), a3, voffA);
            PG8_WAIT_V(8); PG8_WAIT_L(0); PG8_BAR; PG8_MMA(1, 0, At, B0); PG8_MMA(1, 1, At, B1); PG8_BAR; PG8_SCHED;
            } else {
            PG8_LDB(B0, 0, 0); PG8_SCHED; PG8_LDA(At, 0, 0); PG8_STAGE(PG8_SA(1, 1), a1 + hstep, voffA);
            PG8_WAIT_L(8); PG8_BAR; PG8_WAIT_L(0); PG8_MMA(0, 0, At, B0); PG8_BAR; PG8_SCHED;
            PG8_LDB(B1, 0, 1); PG8_STAGE(PG8_SB(0, 0), b2, voffB);
            PG8_BAR; PG8_WAIT_L(0); PG8_MMA(0, 1, At, B1); PG8_BAR;
            PG8_LDA(At, 0, 1); PG8_STAGE(PG8_SA(0, 0), a2, voffA);
            PG8_BAR; PG8_WAIT_L(0); PG8_MMA(1, 0, At, B0); PG8_BAR; PG8_SCHED;
            PG8_STAGE(PG8_SB(0, 1), b2 + hstep, voffB);
            PG8_WAIT_V(6); PG8_BAR; PG8_MMA(1, 1, At, B1); PG8_BAR;
            PG8_LDB(B0, 1, 0); PG8_SCHED; PG8_LDA(At, 1, 0); PG8_STAGE(PG8_SA(0, 1), a2 + hstep, voffA);
            PG8_WAIT_L(8); PG8_BAR; PG8_WAIT_L(0); PG8_MMA(0, 0, At, B0); PG8_BAR; PG8_SCHED;
            PG8_LDB(B1, 1, 1); PG8_STAGE(PG8_SB(1, 0), b3, voffB);
            PG8_BAR; PG8_WAIT_L(0); PG8_MMA(0, 1, At, B1); PG8_BAR;
            PG8_LDA(At, 1, 1); PG8_STAGE(PG8_SA(1, 0), a3, voffA);
            PG8_BAR; PG8_WAIT_L(0); PG8_MMA(1, 0, At, B0); PG8_BAR; PG8_SCHED;
            PG8_STAGE(PG8_SB(1, 1), b3 + hstep, voffB);
            PG8_WAIT_V(6); PG8_BAR; PG8_MMA(1, 1, At, B1); PG8_BAR;
            }
        }
        if constexpr (ALIGN_EPI) { if (wr == 0) PG8_BAR; }
        if constexpr (!Epi::AFTER_DRAIN) { E(acc, cur, wr, wc, fr, fq); S.done(cur); }
        if (!has_next) break;
#pragma unroll
        for (int a = 0; a < 2; ++a)
#pragma unroll
            for (int b = 0; b < 2; ++b)
#pragma unroll
                for (int m = 0; m < 4; ++m)
#pragma unroll
                    for (int n = 0; n < 2; ++n) acc[a][b][m][n] = (f32x4){0.f, 0.f, 0.f, 0.f};
        cur = nxt; cA = nA; cB = nB; ++ui;
        if constexpr (ALIGN_EPI) { if (wr == 1) PG8_BAR; }
    }
    PG8_WAIT_V(0);
    if constexpr (!ALIGN_EPI) { if (wr == 0) PG8_BAR; }
    PG8_BAR;
    if constexpr (Epi::AFTER_DRAIN) { E.fused(acc, cur, wr, wc, fr, fq, lds, wid, lane); S.done(cur); }
#undef PG8_SA
#undef PG8_SB
#undef PG8_STAGE
#undef PG8_LDA
#undef PG8_LDB
#undef PG8_MMA
#undef PG8_WAIT_V
#undef PG8_WAIT_L
#undef PG8_BAR
#undef PG8_SCHED
}
}

#define LAS __attribute__((address_space(3)))
typedef unsigned short bf16;
typedef unsigned v4u __attribute__((ext_vector_type(4)));
typedef unsigned v2u __attribute__((ext_vector_type(2)));
typedef float f32x4 __attribute__((ext_vector_type(4)));
typedef short bf16x8 __attribute__((ext_vector_type(8)));

constexpr int MROWS = 16384, DM = 1024, SEQL = 2048;
constexpr float EPS = 1e-6f;
constexpr int NTHREADS = 512, NWAVES = 8;
#ifndef DBG_NOHGRN
#define DBG_NOHGRN 0
#endif
#ifndef DBG_HG
#define DBG_HG 0
#endif
#ifndef DBG_SEG
#define DBG_SEG -1
#endif
#ifndef DBG_STOP
#define DBG_STOP 0
#endif
constexpr int LDS_BYTES = 163840;
constexpr size_t MiB = 1u << 20;
constexpr size_t WS_CTL = 0;
constexpr size_t WS_BAR = 512 * 1024;
constexpr size_t WS_WIN = 1 * MiB;
constexpr size_t WS_WOUT = 21 * MiB;
constexpr size_t WS_XB = 23 * MiB;
constexpr size_t WS_Y = 55 * MiB;
constexpr size_t WS_PROJ = 87 * MiB;
constexpr size_t WS_EXTRA = WS_PROJ + 144 * MiB;
constexpr size_t WS_LSE = 247 * MiB;
constexpr size_t WS_END = 249 * MiB;

__device__ __forceinline__ float bf2f(unsigned short u) { return __uint_as_float((unsigned)u << 16); }
__device__ __forceinline__ float bflo(unsigned u) { return __uint_as_float(u << 16); }
__device__ __forceinline__ float bfhi(unsigned u) { return __uint_as_float(u & 0xffff0000u); }
typedef float f32x2_t __attribute__((ext_vector_type(2)));
typedef __bf16 bf16x2_t __attribute__((ext_vector_type(2)));
__device__ __forceinline__ unsigned pk2(float lo, float hi) { f32x2_t v = {lo, hi}; bf16x2_t b = __builtin_convertvector(v, bf16x2_t); return __builtin_bit_cast(unsigned, b); }
__device__ __forceinline__ unsigned short f2bf(float f) { return (unsigned short)(pk2(f, 0.f) & 0xffffu); }
__device__ __forceinline__ float silu_f(float x) { return x * __builtin_amdgcn_rcpf(1.f + __expf(-x)); }
__device__ __forceinline__ float gelu_f(float x) { const float u2 = 1.5957691216057308f * (x + 0.044715f * x * x * x); return x * __builtin_amdgcn_rcpf(1.f + __expf(-u2)); }
__device__ __forceinline__ void atomic_add_agent(float* p, float v) { (void)__hip_atomic_fetch_add(p, v, __ATOMIC_RELAXED, __HIP_MEMORY_SCOPE_AGENT); }
__device__ __forceinline__ f32x4 mfma16(bf16x8 a, bf16x8 b, f32x4 c) { return __builtin_amdgcn_mfma_f32_16x16x32_bf16(a, b, c, 0, 0, 0); }

#define XB_TMO      128
#define XB_XCNT(j)  (256  + 64 * (j))
#define XB_XSUB(j)  (1280 + 64 * (j))
#define XB_XGEN(j)  (2304 + 64 * (j))
#define XB_TOP      3328
#define XB_TOPGEN   3392
#define XCD_BAR_WORDS 3456
#define XB_SPIN_CAP (1u << 18)

__device__ __forceinline__ unsigned xb_ld(unsigned* p)              { return __hip_atomic_load(p, __ATOMIC_RELAXED, __HIP_MEMORY_SCOPE_AGENT); }
__device__ __forceinline__ unsigned xb_add(unsigned* p, unsigned v) { return __hip_atomic_fetch_add(p, v, __ATOMIC_RELAXED, __HIP_MEMORY_SCOPE_AGENT); }
__device__ __forceinline__ unsigned xb_xcc_id() { return (unsigned)__builtin_amdgcn_s_getreg((3 << 11) | 20) & 0xFu; }
#define XB_SPIN(cond, bar) do { unsigned _sp = 0; while (cond) { __builtin_amdgcn_s_sleep(1); \
    if ((++_sp & 255u) == 0u) { if (xb_ld(&(bar)[XB_TMO])) break; if (_sp > XB_SPIN_CAP) { atomicAdd(&(bar)[XB_TMO], 1u); break; } } } } while (0)

struct XcdBarrier {
    unsigned* bar; unsigned x;
    volatile LAS unsigned* st;
};

__device__ __forceinline__ XcdBarrier xcd_barrier_post(unsigned* bar, volatile LAS unsigned* st) {
    XcdBarrier b; b.bar = bar; b.x = xb_xcc_id(); b.st = st;
    if (threadIdx.x == 0) (void)xb_add(&bar[XB_XCNT(b.x)], 1u);
    return b;
}
__device__ __forceinline__ void xcd_barrier_complete(unsigned* bar, unsigned x, unsigned& nloc, unsigned& nx) {
    const unsigned G = gridDim.x * gridDim.y * gridDim.z;
    unsigned sum, cnt, mine, sp = 0u;
    for (;;) {
        sum = 0u; cnt = 0u; mine = 0u;
#pragma unroll
        for (unsigned j = 0; j < 16; ++j) { const unsigned c = xb_ld(&bar[XB_XCNT(j)]); sum += c; cnt += (c > 0u) ? 1u : 0u; mine = (j == x) ? c : mine; }
        if (sum == G) break;
        __builtin_amdgcn_s_sleep(1);
        if ((++sp & 255u) == 0u) { if (xb_ld(&bar[XB_TMO])) break; if (sp > XB_SPIN_CAP) { atomicAdd(&bar[XB_TMO], 1u); break; } }
    }
    nloc = mine > 0u ? mine : 1u; nx = cnt > 0u ? cnt : 1u;
}

__device__ __forceinline__ void xcd_barrier(const XcdBarrier& b) {
    asm volatile("s_waitcnt vmcnt(0)" ::: "memory");
    __syncthreads();
    if (threadIdx.x == 0) {
        unsigned* bar = b.bar;
        __builtin_amdgcn_s_waitcnt(0);
        unsigned nloc = b.st[0], nx = b.st[1];
        if (nloc == 0u) { xcd_barrier_complete(bar, b.x, nloc, nx); b.st[0] = nloc; b.st[1] = nx; }
        const unsigned old = xb_add(&bar[XB_XSUB(b.x)], 1u);
        const unsigned gen = old / nloc;
        if (old + 1u == (gen + 1u) * nloc) {
            __builtin_amdgcn_fence(__ATOMIC_RELEASE, "agent");
            asm volatile("s_waitcnt vmcnt(0)" ::: "memory");
            const unsigned og = xb_add(&bar[XB_TOP], 1u);
            const unsigned tg = og / nx;
            if (og + 1u == (tg + 1u) * nx) xb_add(&bar[XB_TOPGEN], 1u);
            else XB_SPIN(xb_ld(&bar[XB_TOPGEN]) == tg, bar);
            __builtin_amdgcn_fence(__ATOMIC_ACQUIRE, "agent");
            xb_add(&bar[XB_XGEN(b.x)], 1u);
            asm volatile("s_waitcnt vmcnt(0)" ::: "memory");
        } else {
            XB_SPIN(xb_ld(&bar[XB_XGEN(b.x)]) == gen, bar);
            __builtin_amdgcn_fence(__ATOMIC_ACQUIRE, "agent");
            asm volatile("s_waitcnt vmcnt(0)" ::: "memory");
        }
    }
    __syncthreads();
}

__device__ __forceinline__ v4u pack8(const float (&y)[8]) { return (v4u){pk2(y[0], y[1]), pk2(y[2], y[3]), pk2(y[4], y[5]), pk2(y[6], y[7])}; }
template <int KIND> struct EpiIn {
    static constexpr bool PERM = true, AFTER_DRAIN = false;
    const float* ssq; int row_base;
    bf16* o0; bf16* o1; bf16* o2; float* of; bf16* Y;
    const float* lbsrc; int idx;
    float* vs1; float* vs2;
    __device__ __forceinline__ void operator()(const f32x4 (&acc)[2][2][4][2], const pg8::Unit& u, int wr, int wc, int fr, int fq) const {
        const int lrow0 = u.pm * 256 + wr * 64 + fr;
        const int cb = wc * 32 + 8 * fq;
        if (KIND == 0) {
            const int region = u.pn >> 2; const int c0 = (u.pn & 3) * 256 + cb;
            float rs[2][4];
#pragma unroll
            for (int ai = 0; ai < 2; ++ai)
#pragma unroll
                for (int m = 0; m < 4; ++m) rs[ai][m] = rsqrtf(ssq[lrow0 + ai * 128 + m * 16] * (1.f / 1024.f) + EPS);
#pragma unroll
            for (int bj = 0; bj < 2; ++bj) {
                const int c = c0 + bj * 128;
                float lb[8] = {0.f, 0.f, 0.f, 0.f, 0.f, 0.f, 0.f, 0.f};
                if (region == 1 && idx != 0) {
                    const f32x4 a00 = *(const f32x4*)(lbsrc + c), a01 = *(const f32x4*)(lbsrc + c + 4), a10 = *(const f32x4*)(lbsrc + 1024 + c), a11 = *(const f32x4*)(lbsrc + 1024 + c + 4);
#pragma unroll
                    for (int j = 0; j < 4; ++j) { lb[j] = __builtin_amdgcn_rcpf(1.f + __expf(a00[j] - a10[j])); lb[4 + j] = __builtin_amdgcn_rcpf(1.f + __expf(a01[j] - a11[j])); }
                }
#pragma unroll
                for (int ai = 0; ai < 2; ++ai)
#pragma unroll
                    for (int m = 0; m < 4; ++m) {
                        const int row = lrow0 + ai * 128 + m * 16; const size_t off = (size_t)row * 1024 + c;
                        const f32x4 v0 = acc[ai][bj][m][0] * rs[ai][m], v1 = acc[ai][bj][m][1] * rs[ai][m];
                        const float v[8] = {v0[0], v0[1], v0[2], v0[3], v1[0], v1[1], v1[2], v1[3]};
                        float y[8];
                        if (region == 0) {
#pragma unroll
                            for (int j = 0; j < 8; ++j) y[j] = silu_f(v[j]);
                            *(v4u*)(o0 + off) = pack8(y);
                        } else if (region == 1) {
                            float lf[8];
#pragma unroll
                            for (int j = 0; j < 8; ++j) {
                                const float om = 1.f - lb[j];
                                const float fc = fminf(fmaxf(v[j], -80.f), 80.f);
                                const float e = __expf(-fc), sg = __builtin_amdgcn_rcpf(1.f + e);
                                y[j] = om * e * sg;
                                lf[j] = __logf(fmaxf(lb[j] + om * sg, 1e-30f));
                            }
                            *(v4u*)(o1 + off) = pack8(y);
                            *(f32x4*)(of + off) = (f32x4){lf[0], lf[1], lf[2], lf[3]}; *(f32x4*)(of + off + 4) = (f32x4){lf[4], lf[5], lf[6], lf[7]};
                        } else if (region == 2) { *(v4u*)(o2 + off) = pack8(v); }
                        else {
#pragma unroll
                            for (int j = 0; j < 8; ++j) y[j] = silu_f(v[j]);
                            *(v4u*)(Y + off) = pack8(y);
                        }
                    }
            }
        } else if (KIND == 1) {
            const bool gate = (u.pn >= 36);
#pragma unroll
            for (int ai = 0; ai < 2; ++ai)
#pragma unroll
                for (int m = 0; m < 4; ++m) {
                    const int lrow = lrow0 + ai * 128 + m * 16; const int row = row_base + lrow;
                    const float rs = rsqrtf(ssq[row] * (1.f / 1024.f) + EPS);
#pragma unroll
                    for (int bj = 0; bj < 2; ++bj) {
                        const int c = cb + bj * 128;
                        const f32x4 v0 = acc[ai][bj][m][0] * rs, v1 = acc[ai][bj][m][1] * rs;
                        const float v[8] = {v0[0], v0[1], v0[2], v0[3], v1[0], v1[1], v1[2], v1[3]};
                        if (!gate) *(v4u*)(o0 + (size_t)lrow * 9216 + u.pn * 256 + c) = pack8(v);
                        else { float y[8];
#pragma unroll
                            for (int j = 0; j < 8; ++j) y[j] = silu_f(v[j]);
                            *(v4u*)(Y + (size_t)row * 1024 + (u.pn - 36) * 256 + c) = pack8(y); }
                    }
                }
        } else {
            const int region = u.pn >> 2; const int c0 = (u.pn & 3) * 256 + cb;
#pragma unroll
            for (int ai = 0; ai < 2; ++ai)
#pragma unroll
                for (int m = 0; m < 4; ++m) {
                    const int row = lrow0 + ai * 128 + m * 16;
                    const float rs = rsqrtf(ssq[row] * (1.f / 1024.f) + EPS);
                    float s1 = 0.f, s2 = 0.f;
#pragma unroll
                    for (int bj = 0; bj < 2; ++bj) {
                        const int c = c0 + bj * 128; const size_t off = (size_t)row * 1024 + c;
                        const f32x4 v0 = acc[ai][bj][m][0] * rs, v1 = acc[ai][bj][m][1] * rs;
                        const float v[8] = {v0[0], v0[1], v0[2], v0[3], v1[0], v1[1], v1[2], v1[3]};
                        float y[8];
                        if (region == 0) {
#pragma unroll
                            for (int j = 0; j < 8; ++j) y[j] = gelu_f(v[j]);
                            *(v4u*)(o0 + off) = pack8(y);
                        } else if (region == 1) {
#pragma unroll
                            for (int j = 0; j < 8; ++j) { y[j] = gelu_f(v[j]); s1 += y[j]; s2 += y[j] * y[j]; }
                            *(v4u*)(o1 + off) = pack8(y);
                        } else {
#pragma unroll
                            for (int j = 0; j < 8; ++j) y[j] = silu_f(v[j]);
                            *(v4u*)(Y + off) = pack8(y);
                        }
                    }
                    if (region == 1) {
                        s1 += __shfl_xor(s1, 16); s1 += __shfl_xor(s1, 32); s2 += __shfl_xor(s2, 16); s2 += __shfl_xor(s2, 32);
                        if (fq == 0) { atomic_add_agent(vs1 + row, s1); atomic_add_agent(vs2 + row, s2); }
                    }
                }
        }
    }
};

struct EpiOut {
    static constexpr bool PERM = true, AFTER_DRAIN = false;
    const float* xin; float* xout; bf16* xb; float* ssq;
    __device__ __forceinline__ void operator()(const f32x4 (&acc)[2][2][4][2], const pg8::Unit& u, int wr, int wc, int fr, int fq) const {
        const int row0 = u.pm * 256 + wr * 64 + fr; const int c0 = u.pn * 256 + wc * 32 + 8 * fq;
#pragma unroll
        for (int ai = 0; ai < 2; ++ai)
#pragma unroll
            for (int m = 0; m < 4; ++m) {
                const int row = row0 + ai * 128 + m * 16; float s2 = 0.f;
#pragma unroll
                for (int bj = 0; bj < 2; ++bj) {
                    const size_t off = (size_t)row * 1024 + c0 + bj * 128;
                    f32x4 x0, x1;
                    if (xin) { x0 = *(const f32x4*)(xin + off); x1 = *(const f32x4*)(xin + off + 4); }
                    else { const v4u xv = *(const v4u*)(xb + off); x0 = (f32x4){bflo(xv.x), bfhi(xv.x), bflo(xv.y), bfhi(xv.y)}; x1 = (f32x4){bflo(xv.z), bfhi(xv.z), bflo(xv.w), bfhi(xv.w)}; }
                    const f32x4 n0 = x0 + acc[ai][bj][m][0], n1 = x1 + acc[ai][bj][m][1];
                    if (xout) { *(f32x4*)(xout + off) = n0; *(f32x4*)(xout + off + 4) = n1; }
                    else *(v4u*)(xb + off) = (v4u){pk2(n0[0], n0[1]), pk2(n0[2], n0[3]), pk2(n1[0], n1[1]), pk2(n1[2], n1[3])};
                    s2 += ((n0[0] * n0[0] + n0[1] * n0[1]) + (n0[2] * n0[2] + n0[3] * n0[3])) + ((n1[0] * n1[0] + n1[1] * n1[1]) + (n1[2] * n1[2] + n1[3] * n1[3]));
                }
                if (ssq) { s2 += __shfl_xor(s2, 16); s2 += __shfl_xor(s2, 32); if (fq == 0) atomic_add_agent(ssq + row, s2); }
            }
    }
};

__device__ __forceinline__ void transpose_item(const float* W, int K, int N, bf16* WT, const float* scale, LAS float* scr, int item, int lane) {
    const int nblk = N / 32, kb = item / nblk, nb = item % nblk, k0 = 64 * kb, n0 = 32 * nb;
    {
        const int q = lane & 7, r = lane >> 3;
        f32x4 v[8];
#pragma unroll
        for (int i = 0; i < 8; ++i) v[i] = *(const f32x4*)(W + (size_t)(k0 + 8 * i + r) * N + n0 + 4 * q);
#pragma unroll
        for (int i = 0; i < 8; ++i) { const int kk = 8 * i + r; f32x4 x = v[i]; if (scale) x = x * scale[k0 + kk];
            scr[kk * 33 + 4 * q + 0] = x[0]; scr[kk * 33 + 4 * q + 1] = x[1]; scr[kk * 33 + 4 * q + 2] = x[2]; scr[kk * 33 + 4 * q + 3] = x[3]; }
    }
    asm volatile("s_waitcnt lgkmcnt(0)" ::: "memory");
    const int c = lane & 7;
#pragma unroll
    for (int j = 0; j < 4; ++j) { const int n = (lane >> 3) + 8 * j; const LAS float* s = scr + (8 * c) * 33 + n;
        v4u o; o.x = pk2(s[0 * 33], s[1 * 33]); o.y = pk2(s[2 * 33], s[3 * 33]); o.z = pk2(s[4 * 33], s[5 * 33]); o.w = pk2(s[6 * 33], s[7 * 33]);
        *(v4u*)(WT + (size_t)(n0 + n) * K + k0 + 8 * c) = o; }
    asm volatile("s_waitcnt lgkmcnt(0)" ::: "memory");
}
__device__ __forceinline__ void convert_weight(const float* W, int K, int N, bf16* WT, const float* scale, LAS unsigned char* lds, int gw, int ngw) {
    if (gw < 0) return;
    int tid_l = threadIdx.x; asm volatile("" : "+v"(tid_l));
    const int lane = tid_l & 63, wave = __builtin_amdgcn_readfirstlane(tid_l >> 6);
    LAS float* scr = (LAS float*)(lds + wave * 16384);
    const int nitems = (K / 64) * (N / 32);
    for (int it = gw; it < nitems; it += ngw) transpose_item(W, K, N, WT, scale, scr, it, lane);
}

typedef short v4i16_t __attribute__((ext_vector_type(4)));
#define LBAR() do { asm volatile("s_waitcnt lgkmcnt(0)" ::: "memory"); __builtin_amdgcn_s_barrier(); asm volatile("" ::: "memory"); } while (0)
__device__ __forceinline__ bf16x8 tr_frag(const LAS bf16* img, int stride, int k0, int n0, int l16, int g4) {
    const LAS bf16* a = img + (k0 + 8 * g4 + (l16 >> 2)) * stride + n0 + 4 * (l16 & 3);
    const v4i16_t lo = __builtin_amdgcn_ds_read_tr16_b64_v4i16((LAS v4i16_t*)a);
    const v4i16_t hi = __builtin_amdgcn_ds_read_tr16_b64_v4i16((LAS v4i16_t*)(a + 4 * stride));
    return (bf16x8){lo[0], lo[1], lo[2], lo[3], hi[0], hi[1], hi[2], hi[3]};
}

constexpr int PP_QT = 0;
constexpr int PP_KT = PP_QT + 64 * 272;
constexpr int PP_K2 = PP_KT + 64 * 272;
constexpr int PP_QX = PP_K2 + 64 * 272;
constexpr int PP_DEC = PP_QX + 48 * 272;
static_assert(PP_DEC + 2048 <= 131072, "prepass lds");
__device__ __forceinline__ void hgrn_prepass(LAS unsigned char* lds, bf16* Q, bf16* KK, const float* LOGF, bf16* PBUF, float* DBUF, int bx, int G) {
    int tid_l = threadIdx.x; asm volatile("" : "+v"(tid_l));
    const int tid = tid_l, lane = tid & 63, w = __builtin_amdgcn_readfirstlane(tid >> 6), l16 = lane & 15, g4 = lane >> 4;
    LAS bf16* Qt = (LAS bf16*)(lds + PP_QT); LAS bf16* Kt = (LAS bf16*)(lds + PP_KT); LAS bf16* K2 = (LAS bf16*)(lds + PP_K2); LAS bf16* QX = (LAS bf16*)(lds + PP_QX); LAS float* DEC = (LAS float*)(lds + PP_DEC);
    const int pk = tid & 127, pi = tid >> 7;
    float lfr[16]; unsigned qr[16], kr[16];
#define PP_LOAD(uu) do { const int c_ = (uu) & 31, bh_ = (uu) >> 5; const size_t rb_ = ((size_t)(bh_ >> 3) * SEQL + 64 * c_ + 16 * pi) * 1024 + (size_t)(bh_ & 7) * 128 + pk; \
        _Pragma("unroll") for (int j = 0; j < 16; ++j) { const size_t a_ = rb_ + (size_t)j * 1024; lfr[j] = LOGF[a_]; qr[j] = Q[a_]; kr[j] = KK[a_]; } } while (0)
    int u = bx;
    if (u < 2048) PP_LOAD(u);
#pragma unroll 1
    for (; u < 2048; u += G) {
        const int c = u & 31, bh = u >> 5; const size_t m0 = (size_t)(bh >> 3) * SEQL + 64 * c; const int hc = (bh & 7) * 128;
        {
            float bl[16], kkv[16]; float bsum = 0.f;
#pragma unroll
            for (int j = 0; j < 16; ++j) {
                const float q = bf2f((unsigned short)qr[j]); const float kk = bf2f((unsigned short)kr[j]);
                bsum += lfr[j]; bl[j] = bsum; kkv[j] = kk;
                Qt[(16 * pi + j) * 136 + pk] = f2bf(q * __expf(bsum));
                Kt[(16 * pi + j) * 136 + pk] = f2bf(kk * __expf(fminf(-bsum, 80.f)));
            }
            DEC[pi * 128 + pk] = __expf(bsum);
#pragma unroll
            for (int j = 0; j < 16; ++j) K2[(16 * pi + j) * 136 + pk] = f2bf(kkv[j] * __expf(bsum - bl[j]));
        }
        if (u + G < 2048) PP_LOAD(u + G);
        LBAR();
        {
            const float d0 = DEC[pk], d1 = DEC[128 + pk], d2 = DEC[256 + pk], d3 = DEC[384 + pk];
            const float eq = pi == 0 ? 1.f : (pi == 1 ? d0 : (pi == 2 ? d0 * d1 : d0 * d1 * d2));
            const float gk = pi == 3 ? 1.f : (pi == 2 ? d3 : (pi == 1 ? d2 * d3 : d1 * d2 * d3));
            const size_t gb = (m0 + 16 * pi) * 1024 + hc + pk;
#pragma unroll
            for (int j = 0; j < 16; ++j) {
                const float qt = bf2f(Qt[(16 * pi + j) * 136 + pk]), k2 = bf2f(K2[(16 * pi + j) * 136 + pk]);
                Q[gb + (size_t)j * 1024] = f2bf(qt * eq); KK[gb + (size_t)j * 1024] = f2bf(k2 * gk);
            }
#pragma unroll
            for (int jj = 0; jj < 12; ++jj) {
                const int r = 12 * pi + jj, tile = r >> 4, rr = r & 15;
                const float f = tile == 0 ? d1 : (tile == 1 ? d2 : d1 * d2);
                QX[r * 136 + pk] = f2bf(bf2f(Qt[((tile == 0 ? 32 : 48) + rr) * 136 + pk]) * f);
            }
            if (pi == 0) DBUF[(size_t)u * 128 + pk] = (d0 * d1) * (d2 * d3);
        }
        LBAR();
#pragma unroll 1
        for (int job = w; job < 12; job += 8) {
            int bi, bj; const LAS bf16* Ab; const LAS bf16* Bb; bool diag = false, zero = false;
            if (job < 4) { bi = job; bj = job; Ab = Kt + 16 * bj * 136; Bb = Qt + 16 * bi * 136; diag = true; }
            else if (job < 7) { bi = job - 3; bj = job - 4; Ab = K2 + 16 * bj * 136; Bb = Qt + 16 * bi * 136; }
            else if (job == 7) { bi = 2; bj = 0; Ab = K2; Bb = QX; }
            else if (job == 8) { bi = 3; bj = 1; Ab = K2 + 16 * 136; Bb = QX + 16 * 136; }
            else if (job == 9) { bi = 3; bj = 0; Ab = K2; Bb = QX + 32 * 136; }
            else if (job == 10) { bi = 0; bj = 1; Ab = Kt; Bb = Qt; zero = true; }
            else { bi = 2; bj = 3; Ab = Kt; Bb = Qt; zero = true; }
            f32x4 a4 = (f32x4){0.f, 0.f, 0.f, 0.f};
            if (!zero) {
#pragma unroll
                for (int ks = 0; ks < 4; ++ks) {
                    const bf16x8 a = *(const LAS bf16x8*)(Ab + l16 * 136 + 32 * ks + 8 * g4);
                    const bf16x8 bq = *(const LAS bf16x8*)(Bb + l16 * 136 + 32 * ks + 8 * g4);
                    a4 = mfma16(a, bq, a4);
                }
            }
            float pv[4];
#pragma unroll
            for (int r = 0; r < 4; ++r) pv[r] = (!diag || (4 * g4 + r <= l16)) ? a4[r] : 0.f;
            *(v2u*)(PBUF + (size_t)u * 4096 + (16 * bi + l16) * 64 + 16 * bj + 4 * g4) = (v2u){pk2(pv[0], pv[1]), pk2(pv[2], pv[3])};
        }
        LBAR();
    }
#undef PP_LOAD
}

constexpr int HS_QT = 0;
constexpr int HS_K2 = HS_QT + 64 * 272;
constexpr int HS_VR = HS_K2 + 64 * 272;
constexpr int HS_P = HS_VR + 64 * 272;
constexpr int HS_DEC = HS_P + 64 * 144;
constexpr int HS_SET = HS_DEC + 512;
constexpr int H_SSQ = 2 * HS_SET;
constexpr int H_OB = H_SSQ + 4096;
constexpr int H_END = H_OB + 2 * 64 * 272;
static_assert(H_END <= LDS_BYTES - 64 && (HS_SET % 16) == 0, "hgrn lds");
__device__ __forceinline__ v4u tr_pair(const LAS bf16* a, int stride4) {
    const v4i16_t lo = __builtin_amdgcn_ds_read_tr16_b64_v4i16((LAS v4i16_t*)a);
    const v4i16_t hi = __builtin_amdgcn_ds_read_tr16_b64_v4i16((LAS v4i16_t*)(a + stride4));
    const v2u l2 = __builtin_bit_cast(v2u, lo), h2 = __builtin_bit_cast(v2u, hi);
    return (v4u){l2.x, l2.y, h2.x, h2.y};
}
__device__ __forceinline__ void hgrn_unit(LAS unsigned char* lds, int b, int h, const bf16* Q, const bf16* KK, const bf16* V, const bf16* PBUF, const float* DBUF, bf16* Y, const float* onw) {
    int tid_l = threadIdx.x; asm volatile("" : "+v"(tid_l));
    const int tid = tid_l, lane = tid & 63, w = __builtin_amdgcn_readfirstlane(tid >> 6), l16 = lane & 15, g4 = lane >> 4;
    const bool cw = (w < 4);
    const int ubase = (b * 8 + h) * 32;
    if (!cw) {
        const int lt = tid - 256;
        v4u lqA[4], lkA[4], lvA[4], lpA[2], ldA;
#define LD_ISSUE(cc, lq, lk, lv, lp, ld) do { const size_t mb_ = (size_t)b * SEQL + 64 * (cc); \
            _Pragma("unroll") for (int jj = 0; jj < 4; ++jj) { const int id_ = lt + 256 * jj; const size_t o_ = (mb_ + (id_ >> 4)) * 1024 + (size_t)h * 128 + 8 * (id_ & 15); \
                lq[jj] = *(const v4u*)(Q + o_); lk[jj] = *(const v4u*)(KK + o_); lv[jj] = *(const v4u*)(V + o_); } \
            _Pragma("unroll") for (int jj = 0; jj < 2; ++jj) lp[jj] = *(const v4u*)(PBUF + (size_t)(ubase + (cc)) * 4096 + 8 * (lt + 256 * jj)); \
            ld = (v4u){0u, 0u, 0u, 0u}; if (lt < 32) ld = *(const v4u*)(DBUF + (size_t)(ubase + (cc)) * 128 + 4 * lt); } while (0)
#define LD_WRITE(set, lq, lk, lv, lp, ld) do { LAS unsigned char* sb_ = lds + (set) * HS_SET; \
            _Pragma("unroll") for (int jj = 0; jj < 4; ++jj) { const int id_ = lt + 256 * jj; const int e_ = (id_ >> 4) * 136 + 8 * (id_ & 15); \
                *(LAS v4u*)((LAS bf16*)(sb_ + HS_QT) + e_) = lq[jj]; *(LAS v4u*)((LAS bf16*)(sb_ + HS_K2) + e_) = lk[jj]; *(LAS v4u*)((LAS bf16*)(sb_ + HS_VR) + e_) = lv[jj]; } \
            _Pragma("unroll") for (int jj = 0; jj < 2; ++jj) { const int id_ = lt + 256 * jj; *(LAS v4u*)((LAS bf16*)(sb_ + HS_P) + (id_ >> 3) * 72 + 8 * (id_ & 7)) = lp[jj]; } \
            if (lt < 32) *(LAS v4u*)((LAS float*)(sb_ + HS_DEC) + 4 * lt) = ld; } while (0)
        const int foct = lt & 15;
        const f32x4 fw0 = *(const f32x4*)(onw + 8 * foct), fw1 = *(const f32x4*)(onw + 8 * foct + 4);
        v4u gt[4];
#define GATE_LOAD(cc) do { _Pragma("unroll") for (int jj = 0; jj < 4; ++jj) gt[jj] = *(const v4u*)(Y + ((size_t)b * SEQL + 64 * (cc) + ((lt + 256 * jj) >> 4)) * 1024 + (size_t)h * 128 + 8 * foct); } while (0)
#define FINISH(cc) do { const LAS float* sq_ = (const LAS float*)(lds + H_SSQ) + ((cc) & 1) * 512; const LAS bf16* ob_ = (const LAS bf16*)(lds + H_OB) + ((cc) & 1) * (64 * 136); \
            _Pragma("unroll") for (int jj = 0; jj < 4; ++jj) { const int t_ = (lt + 256 * jj) >> 4; \
                const f32x4 s0_ = *(const LAS f32x4*)(sq_ + t_ * 8), s1_ = *(const LAS f32x4*)(sq_ + t_ * 8 + 4); \
                const float rs_ = rsqrtf((((s0_[0] + s0_[1]) + (s0_[2] + s0_[3])) + ((s1_[0] + s1_[1]) + (s1_[2] + s1_[3]))) * (1.f / 128.f) + EPS); \
                const v4u o_ = *(const LAS v4u*)(ob_ + t_ * 136 + 8 * foct); const v4u g_ = gt[jj]; v4u y_; \
                y_.x = pk2(bflo(o_.x) * rs_ * fw0[0] * bflo(g_.x), bfhi(o_.x) * rs_ * fw0[1] * bfhi(g_.x)); y_.y = pk2(bflo(o_.y) * rs_ * fw0[2] * bflo(g_.y), bfhi(o_.y) * rs_ * fw0[3] * bfhi(g_.y)); \
                y_.z = pk2(bflo(o_.z) * rs_ * fw1[0] * bflo(g_.z), bfhi(o_.z) * rs_ * fw1[1] * bfhi(g_.z)); y_.w = pk2(bflo(o_.w) * rs_ * fw1[2] * bflo(g_.w), bfhi(o_.w) * rs_ * fw1[3] * bfhi(g_.w)); \
                *(v4u*)(Y + ((size_t)b * SEQL + 64 * (cc) + t_) * 1024 + (size_t)h * 128 + 8 * foct) = y_; } } while (0)
        LD_ISSUE(0, lqA, lkA, lvA, lpA, ldA);
        LD_WRITE(0, lqA, lkA, lvA, lpA, ldA); LD_ISSUE(1, lqA, lkA, lvA, lpA, ldA);
        GATE_LOAD(0);
        LBAR();
#pragma unroll 1
        for (int c = 0; c < 32; ++c) {
            if (c > 0) { FINISH(c - 1); GATE_LOAD(c); }
            if (c + 1 < 32) { LD_WRITE((c + 1) & 1, lqA, lkA, lvA, lpA, ldA); if (c + 2 < 32) LD_ISSUE(c + 2, lqA, lkA, lvA, lpA, ldA); }
            LBAR();
        }
        FINISH(31);
#undef GATE_LOAD
#undef FINISH
#undef LD_ISSUE
#undef LD_WRITE
        return;
    }
    const int wt = 2 * w;
    __builtin_amdgcn_s_setprio(2);
    LAS float* SSQ = (LAS float*)(lds + H_SSQ);
    f32x4 sacc0[8], sacc1[8];
#pragma unroll
    for (int i = 0; i < 8; ++i) { sacc0[i] = (f32x4){0.f, 0.f, 0.f, 0.f}; sacc1[i] = (f32x4){0.f, 0.f, 0.f, 0.f}; }
    const int qoff = l16 * 136 + 4 * g4;
    const int voff = (8 * g4 + (l16 >> 2)) * 136 + 16 * wt + 4 * (l16 & 3);
    const int koff = (8 * g4 + (l16 >> 2)) * 136 + 4 * (l16 & 3);
    const int poff = l16 * 72 + 8 * g4;
    LBAR();
#pragma unroll 1
    for (int c = 0; c < 32; ++c) {
        const size_t m0 = (size_t)b * SEQL + 64 * c;
        LAS unsigned char* sb = lds + (c & 1) * HS_SET;
        const LAS bf16* qbase = (const LAS bf16*)(sb + HS_QT) + qoff; const LAS bf16* vbase = (const LAS bf16*)(sb + HS_VR) + voff; const LAS bf16* kbase = (const LAS bf16*)(sb + HS_K2) + koff;
        const LAS bf16* pbase = (const LAS bf16*)(sb + HS_P) + poff; const LAS float* dbase = (const LAS float*)(sb + HS_DEC) + 4 * g4;
        LAS float* sqw = SSQ + (c & 1) * 512;
        LAS bf16* obw = (LAS bf16*)(lds + H_OB) + (c & 1) * (64 * 136) + l16 * 136 + 16 * wt + 4 * g4;
        v4u a0[4], a1[4];
#pragma unroll
        for (int kp = 0; kp < 4; ++kp) {
            a0[kp] = (v4u){pk2(sacc0[2 * kp][0], sacc0[2 * kp][1]), pk2(sacc0[2 * kp][2], sacc0[2 * kp][3]), pk2(sacc0[2 * kp + 1][0], sacc0[2 * kp + 1][1]), pk2(sacc0[2 * kp + 1][2], sacc0[2 * kp + 1][3])};
            a1[kp] = (v4u){pk2(sacc1[2 * kp][0], sacc1[2 * kp][1]), pk2(sacc1[2 * kp][2], sacc1[2 * kp][3]), pk2(sacc1[2 * kp + 1][0], sacc1[2 * kp + 1][1]), pk2(sacc1[2 * kp + 1][2], sacc1[2 * kp + 1][3])};
        }
        v4u av0[2], av1[2];
#pragma unroll
        for (int ks = 0; ks < 2; ++ks) { av0[ks] = tr_pair(vbase + 32 * ks * 136, 4 * 136); av1[ks] = tr_pair(vbase + 32 * ks * 136 + 16, 4 * 136); }
#pragma unroll
        for (int ti = 0; ti < 4; ++ti) {
            v2u qf[8]; v4u pf[2];
#pragma unroll
            for (int kp = 0; kp < 4; ++kp) { qf[2 * kp] = *(const LAS v2u*)(qbase + 16 * ti * 136 + 32 * kp); qf[2 * kp + 1] = *(const LAS v2u*)(qbase + 16 * ti * 136 + 32 * kp + 16); }
            pf[0] = *(const LAS v4u*)(pbase + 16 * ti * 72); pf[1] = *(const LAS v4u*)(pbase + 16 * ti * 72 + 32);
            __builtin_amdgcn_sched_barrier(0);
            f32x4 o0 = (f32x4){0.f, 0.f, 0.f, 0.f}, o1 = o0;
#pragma unroll
            for (int kp = 0; kp < 4; ++kp) {
                const bf16x8 bq = __builtin_bit_cast(bf16x8, ((v4u){qf[2 * kp].x, qf[2 * kp].y, qf[2 * kp + 1].x, qf[2 * kp + 1].y}));
                o0 = mfma16(__builtin_bit_cast(bf16x8, a0[kp]), bq, o0); o1 = mfma16(__builtin_bit_cast(bf16x8, a1[kp]), bq, o1);
            }
            o0 = mfma16(__builtin_bit_cast(bf16x8, av0[0]), __builtin_bit_cast(bf16x8, pf[0]), o0); o1 = mfma16(__builtin_bit_cast(bf16x8, av1[0]), __builtin_bit_cast(bf16x8, pf[0]), o1);
            if (ti >= 2) { o0 = mfma16(__builtin_bit_cast(bf16x8, av0[1]), __builtin_bit_cast(bf16x8, pf[1]), o0); o1 = mfma16(__builtin_bit_cast(bf16x8, av1[1]), __builtin_bit_cast(bf16x8, pf[1]), o1); }
            {
                float sa = (o0[0] * o0[0] + o0[1] * o0[1]) + (o0[2] * o0[2] + o0[3] * o0[3]), sb2 = (o1[0] * o1[0] + o1[1] * o1[1]) + (o1[2] * o1[2] + o1[3] * o1[3]);
                sa += __shfl_xor(sa, 16); sa += __shfl_xor(sa, 32); sb2 += __shfl_xor(sb2, 16); sb2 += __shfl_xor(sb2, 32);
                if (g4 == 0) { sqw[(16 * ti + l16) * 8 + wt] = sa; sqw[(16 * ti + l16) * 8 + wt + 1] = sb2; }
                *(LAS v2u*)(obw + 16 * ti * 136) = (v2u){pk2(o0[0], o0[1]), pk2(o0[2], o0[3])}; *(LAS v2u*)(obw + 16 * ti * 136 + 16) = (v2u){pk2(o1[0], o1[1]), pk2(o1[2], o1[3])};
            }
        }
#pragma unroll
        for (int kh = 0; kh < 2; ++kh) {
            v4u ak[4][2]; f32x4 dch[4];
#pragma unroll
            for (int kt = 0; kt < 4; ++kt) { ak[kt][0] = tr_pair(kbase + 16 * (4 * kh + kt), 4 * 136); ak[kt][1] = tr_pair(kbase + 32 * 136 + 16 * (4 * kh + kt), 4 * 136); dch[kt] = *(const LAS f32x4*)(dbase + 16 * (4 * kh + kt)); }
            __builtin_amdgcn_sched_barrier(0);
#pragma unroll
            for (int kt = 0; kt < 4; ++kt) {
                const int k8 = 4 * kh + kt;
                sacc0[k8] = mfma16(__builtin_bit_cast(bf16x8, ak[kt][0]), __builtin_bit_cast(bf16x8, av0[0]), sacc0[k8] * dch[kt]); sacc1[k8] = mfma16(__builtin_bit_cast(bf16x8, ak[kt][0]), __builtin_bit_cast(bf16x8, av1[0]), sacc1[k8] * dch[kt]);
                sacc0[k8] = mfma16(__builtin_bit_cast(bf16x8, ak[kt][1]), __builtin_bit_cast(bf16x8, av0[1]), sacc0[k8]); sacc1[k8] = mfma16(__builtin_bit_cast(bf16x8, ak[kt][1]), __builtin_bit_cast(bf16x8, av1[1]), sacc1[k8]);
            }
        }
        LBAR();
    }
    __builtin_amdgcn_s_setprio(0);
}

constexpr int AT_KS = 0;
constexpr int AT_VS = 256 * 144;
constexpr int AT_END = AT_VS + 256 * 160;
static_assert(AT_END <= 131072, "attn lds");

__device__ __forceinline__ void attn_phase(LAS unsigned char* lds, const bf16* PROJ, const bf16* Ygate, bf16* OG0, bf16* OG1, bf16* OG2, float* LSE, const float* qnw, const float* knw, int bx, int G) {
    int tid_l = threadIdx.x; asm volatile("" : "+v"(tid_l));
    const int tid = tid_l, lane = tid & 63, w = __builtin_amdgcn_readfirstlane(tid >> 6), l16 = lane & 15, g4 = lane >> 4;
    LAS bf16* Ks = (LAS bf16*)(lds + AT_KS); LAS bf16* Vs = (LAS bf16*)(lds + AT_VS);
    const int oct = tid & 7;
    v4u kr[4], vr[4], qr[2];
#define AT_LOAD(tt) do { const int sub_ = (tt) & 15, gi_ = ((tt) >> 4) % 3, bh_ = (tt) / 48, h_ = bh_ & 15, bl_ = bh_ >> 4; \
        const int sh_ = 2 * gi_, d_ = 1 << sh_, r_ = sub_ & (d_ - 1), n_ = sub_ >> sh_; const int colq_ = gi_ * 3072 + h_ * 64; \
        _Pragma("unroll") for (int jj = 0; jj < 4; ++jj) { const int key_ = (tid >> 3) + 64 * jj; const int p_ = 128 * (n_ - 1) + key_; \
            kr[jj] = (v4u){0u, 0u, 0u, 0u}; vr[jj] = (v4u){0u, 0u, 0u, 0u}; \
            if (p_ >= 0) { const size_t row_ = (size_t)bl_ * SEQL + (size_t)p_ * d_ + r_; kr[jj] = *(const v4u*)(PROJ + row_ * 9216 + colq_ + 1024 + 8 * oct); vr[jj] = *(const v4u*)(PROJ + row_ * 9216 + colq_ + 2048 + 8 * oct); } } \
        { const size_t qrow_ = (size_t)bl_ * SEQL + (size_t)(128 * n_ + 16 * w + l16) * d_ + r_; \
          _Pragma("unroll") for (int ks = 0; ks < 2; ++ks) qr[ks] = *(const v4u*)(PROJ + qrow_ * 9216 + colq_ + 32 * ks + 8 * g4); } } while (0)
    int t = bx;
    if (t < 3072) AT_LOAD(t);
#pragma unroll 1
    for (; t < 3072; t += G) {
        const int sub = t & 15, gi = (t >> 4) % 3, bh = t / 48, h = bh & 15, bl = bh >> 4;
        const int sh = 2 * gi, d = 1 << sh, r = sub & (d - 1), n = sub >> sh;
        const float ad = exp2f(-8.f * (float)(gi * 16 + h + 1) / 48.f) * (float)d;
        bf16* OG = gi == 0 ? OG0 : (gi == 1 ? OG1 : OG2);
        {
            const f32x4 kw0 = *(const f32x4*)(knw + gi * 64 + 8 * oct), kw1 = *(const f32x4*)(knw + gi * 64 + 8 * oct + 4);
#pragma unroll
            for (int jj = 0; jj < 4; ++jj) {
                const int key = (tid >> 3) + 64 * jj; const v4u kq = kr[jj];
                float kf[8] = {bflo(kq.x), bfhi(kq.x), bflo(kq.y), bfhi(kq.y), bflo(kq.z), bfhi(kq.z), bflo(kq.w), bfhi(kq.w)};
                float ss = 0.f;
#pragma unroll
                for (int e = 0; e < 8; ++e) ss += kf[e] * kf[e];
                ss += __shfl_xor(ss, 1); ss += __shfl_xor(ss, 2); ss += __shfl_xor(ss, 4);
                const float rs = rsqrtf(ss * (1.f / 64.f) + EPS);
                v4u ko; ko.x = pk2(kf[0] * rs * kw0[0], kf[1] * rs * kw0[1]); ko.y = pk2(kf[2] * rs * kw0[2], kf[3] * rs * kw0[3]);
                ko.z = pk2(kf[4] * rs * kw1[0], kf[5] * rs * kw1[1]); ko.w = pk2(kf[6] * rs * kw1[2], kf[7] * rs * kw1[3]);
                *(LAS v4u*)(Ks + key * 72 + 8 * oct) = ko;
                *(LAS v4u*)(Vs + key * 80 + 8 * oct) = vr[jj];
            }
        }
        const int qi = 16 * w + l16;
        const size_t qrow = (size_t)bl * SEQL + (size_t)(128 * n + qi) * d + r;
        bf16x8 qreg[2];
        {
            float qf[2][8]; float ss = 0.f;
#pragma unroll
            for (int ks = 0; ks < 2; ++ks) {
                const v4u qq = qr[ks];
                qf[ks][0] = bflo(qq.x); qf[ks][1] = bfhi(qq.x); qf[ks][2] = bflo(qq.y); qf[ks][3] = bfhi(qq.y); qf[ks][4] = bflo(qq.z); qf[ks][5] = bfhi(qq.z); qf[ks][6] = bflo(qq.w); qf[ks][7] = bfhi(qq.w);
#pragma unroll
                for (int e = 0; e < 8; ++e) ss += qf[ks][e] * qf[ks][e];
            }
            ss += __shfl_xor(ss, 16); ss += __shfl_xor(ss, 32);
            const float rs = rsqrtf(ss * (1.f / 64.f) + EPS) * 0.125f;
#pragma unroll
            for (int ks = 0; ks < 2; ++ks) {
                const f32x4 w0 = *(const f32x4*)(qnw + gi * 64 + 32 * ks + 8 * g4), w1 = *(const f32x4*)(qnw + gi * 64 + 32 * ks + 8 * g4 + 4);
                v4u tq; tq.x = pk2(qf[ks][0] * rs * w0[0], qf[ks][1] * rs * w0[1]); tq.y = pk2(qf[ks][2] * rs * w0[2], qf[ks][3] * rs * w0[3]);
                tq.z = pk2(qf[ks][4] * rs * w1[0], qf[ks][5] * rs * w1[1]); tq.w = pk2(qf[ks][6] * rs * w1[2], qf[ks][7] * rs * w1[3]);
                qreg[ks] = __builtin_bit_cast(bf16x8, tq);
            }
        }
        v4u gg[2];
#pragma unroll
        for (int j = 0; j < 2; ++j) gg[j] = *(const v4u*)(Ygate + qrow * 1024 + (size_t)h * 64 + 32 * j + 8 * g4);
        LBAR();
        if (t + G < 3072) AT_LOAD(t + G);
        const int tlo = (n == 0) ? 8 : 0;
        f32x4 sc[9]; float mx = -3.0e38f;
#pragma unroll
        for (int t9 = 0; t9 < 9; ++t9) {
            const int T = w + t9;
            if (T >= tlo) {
                f32x4 a4 = (f32x4){0.f, 0.f, 0.f, 0.f};
#pragma unroll
                for (int ks = 0; ks < 2; ++ks) { const bf16x8 a = *(const LAS bf16x8*)(Ks + (16 * T + l16) * 72 + 32 * ks + 8 * g4); a4 = mfma16(a, qreg[ks], a4); }
#pragma unroll
                for (int rr = 0; rr < 4; ++rr) {
                    const int kj = 16 * T + 4 * g4 + rr; const int dist = 128 + qi - kj;
                    const bool valid = (dist >= 0) && (dist <= 128);
                    const float sv = valid ? (a4[rr] - ad * (float)dist) : -1e30f;
                    sc[t9][rr] = sv; mx = fmaxf(mx, sv);
                }
            } else sc[t9] = (f32x4){-1e30f, -1e30f, -1e30f, -1e30f};
        }
        mx = fmaxf(mx, __shfl_xor(mx, 16)); mx = fmaxf(mx, __shfl_xor(mx, 32));
        float sum = 0.f;
#pragma unroll
        for (int t9 = 0; t9 < 9; ++t9)
#pragma unroll
            for (int rr = 0; rr < 4; ++rr) { const float p = __expf(sc[t9][rr] - mx); sc[t9][rr] = p; sum += p; }
        sum += __shfl_xor(sum, 16); sum += __shfl_xor(sum, 32);
        const float lse = mx + __logf(sum), inv = 1.f / sum;
        f32x4 oacc[4];
#pragma unroll
        for (int dt = 0; dt < 4; ++dt) oacc[dt] = (f32x4){0.f, 0.f, 0.f, 0.f};
#pragma unroll
        for (int k2 = 0; k2 < 5; ++k2) {
            const int T0 = w + 2 * k2;
            if (T0 + 1 >= tlo) {
                v4u bpu; bpu.x = pk2(sc[2 * k2][0], sc[2 * k2][1]); bpu.y = pk2(sc[2 * k2][2], sc[2 * k2][3]);
                if (k2 < 4) { bpu.z = pk2(sc[(2 * k2 + 1) % 9][0], sc[(2 * k2 + 1) % 9][1]); bpu.w = pk2(sc[(2 * k2 + 1) % 9][2], sc[(2 * k2 + 1) % 9][3]); } else { bpu.z = 0u; bpu.w = 0u; }
                const bf16x8 bp = __builtin_bit_cast(bf16x8, bpu);
                const LAS bf16* vb = Vs + (16 * T0 + 4 * g4 + (l16 >> 2)) * 80 + 8 * (l16 & 3);
#pragma unroll
                for (int dt = 0; dt < 4; ++dt) {
                    const int co = 32 * (dt >> 1) + 4 * (dt & 1);
                    const v4i16_t lo = __builtin_amdgcn_ds_read_tr16_b64_v4i16((LAS v4i16_t*)(vb + co));
                    v4i16_t hi = (v4i16_t){0, 0, 0, 0};
                    if (k2 < 4) hi = __builtin_amdgcn_ds_read_tr16_b64_v4i16((LAS v4i16_t*)(vb + 16 * 80 + co));
                    oacc[dt] = mfma16((bf16x8){lo[0], lo[1], lo[2], lo[3], hi[0], hi[1], hi[2], hi[3]}, bp, oacc[dt]);
                }
            }
        }
#pragma unroll
        for (int j = 0; j < 2; ++j) {
            const size_t off = qrow * 1024 + (size_t)h * 64 + 32 * j + 8 * g4; const v4u g = gg[j]; const f32x4 e = oacc[2 * j], o = oacc[2 * j + 1];
            v4u y;
            y.x = pk2(e[0] * inv * bflo(g.x), e[1] * inv * bfhi(g.x)); y.y = pk2(e[2] * inv * bflo(g.y), e[3] * inv * bfhi(g.y));
            y.z = pk2(o[0] * inv * bflo(g.z), o[1] * inv * bfhi(g.z)); y.w = pk2(o[2] * inv * bflo(g.w), o[3] * inv * bfhi(g.w));
            *(v4u*)(OG + off) = y;
        }
        if (g4 == 0) LSE[((size_t)gi * 8192 + qrow) * 16 + h] = lse;
        LBAR();
    }
#undef AT_LOAD
}

constexpr int G_WA = 0;
constexpr int G_VT = 128 * 272;
__device__ __forceinline__ void gmlp_stage_w(LAS unsigned char* lds, int g, const float* ws) {
    int tid_l = threadIdx.x; asm volatile("" : "+v"(tid_l));
    const int tid = tid_l; LAS bf16* Wa = (LAS bf16*)(lds + G_WA);
    const int t = tid >> 2, sq = (tid & 3) * 32;
    const float* wrow = ws + ((size_t)g * 128 + t) * 128 + sq;
#pragma unroll
    for (int j = 0; j < 8; ++j) {
        const f32x4 v = *(const f32x4*)(wrow + 4 * j); const int s = sq + 4 * j;
        const float a0 = (s + 0 <= t) ? v[0] : 0.f, a1 = (s + 1 <= t) ? v[1] : 0.f, a2 = (s + 2 <= t) ? v[2] : 0.f, a3 = (s + 3 <= t) ? v[3] : 0.f;
        *(LAS v2u*)(Wa + t * 136 + s) = (v2u){pk2(a0, a1), pk2(a2, a3)};
    }
}
__device__ __forceinline__ void gmlp_unit(LAS unsigned char* lds, int unit, const bf16* U, const bf16* Vb, bf16* Y, const float* vs1, const float* vs2,
                                          const float* lnw, const float* lnb, const float* bs) {
    int tid_l = threadIdx.x; asm volatile("" : "+v"(tid_l));
    const int tid = tid_l, lane = tid & 63, w = __builtin_amdgcn_readfirstlane(tid >> 6), l16 = lane & 15, g4 = lane >> 4;
    LAS bf16* Wa = (LAS bf16*)(lds + G_WA); LAS bf16* Vt = (LAS bf16*)(lds + G_VT);
    const int g = unit & 7, bn = unit >> 3;
    const size_t m0 = (size_t)bn * 128; const int c0 = g * 128;
    const int t = 16 * w + l16;
    v4u uu[4], gg[4];
#pragma unroll
    for (int j = 0; j < 4; ++j) { const size_t off = (m0 + t) * 1024 + c0 + 32 * j + 8 * g4; uu[j] = *(const v4u*)(U + off); gg[j] = *(const v4u*)(Y + off); }
    {
        const int s = tid >> 2, cq = (tid & 3) * 32;
        const size_t row = m0 + s;
        const float mean = vs1[row] * (1.f / 1024.f); const float var = vs2[row] * (1.f / 1024.f) - mean * mean; const float rstd = rsqrtf(fmaxf(var, 0.f) + EPS);
#pragma unroll
        for (int j = 0; j < 4; ++j) {
            const int cc = cq + 8 * j;
            const v4u vr = *(const v4u*)(Vb + row * 1024 + c0 + cc);
            const f32x4 w0 = *(const f32x4*)(lnw + c0 + cc), w1 = *(const f32x4*)(lnw + c0 + cc + 4), b0 = *(const f32x4*)(lnb + c0 + cc), b1 = *(const f32x4*)(lnb + c0 + cc + 4);
            const float y8[8] = {(bflo(vr.x) - mean) * rstd * w0[0] + b0[0], (bfhi(vr.x) - mean) * rstd * w0[1] + b0[1], (bflo(vr.y) - mean) * rstd * w0[2] + b0[2], (bfhi(vr.y) - mean) * rstd * w0[3] + b0[3],
                                 (bflo(vr.z) - mean) * rstd * w1[0] + b1[0], (bfhi(vr.z) - mean) * rstd * w1[1] + b1[1], (bflo(vr.w) - mean) * rstd * w1[2] + b1[2], (bfhi(vr.w) - mean) * rstd * w1[3] + b1[3]};
            *(LAS v4u*)(Vt + s * 144 + cc) = pack8(y8);
        }
    }
    LBAR();
    bf16x8 bw[4];
#pragma unroll
    for (int ks = 0; ks < 4; ++ks) bw[ks] = *(const LAS bf16x8*)(Wa + (16 * w + l16) * 136 + 32 * ks + 8 * g4);
    const float bias = bs[g * 128 + t];
#pragma unroll
    for (int j = 0; j < 4; ++j) {
        const LAS bf16* vb = Vt + (8 * g4 + (l16 >> 2)) * 144 + 32 * j + 8 * (l16 & 3);
        f32x4 e4 = (f32x4){0.f, 0.f, 0.f, 0.f}, o4 = e4;
#pragma unroll
        for (int ks = 0; ks < 4; ++ks) {
            const v4u ae = tr_pair(vb + 32 * ks * 144, 4 * 144), ao = tr_pair(vb + 32 * ks * 144 + 4, 4 * 144);
            e4 = mfma16(__builtin_bit_cast(bf16x8, ae), bw[ks], e4); o4 = mfma16(__builtin_bit_cast(bf16x8, ao), bw[ks], o4);
        }
        const size_t off = (m0 + t) * 1024 + c0 + 32 * j + 8 * g4;
        const v4u u4 = uu[j], g4v = gg[j];
        v4u y;
        y.x = pk2(bflo(u4.x) * (e4[0] + bias) * bflo(g4v.x), bfhi(u4.x) * (e4[1] + bias) * bfhi(g4v.x)); y.y = pk2(bflo(u4.y) * (e4[2] + bias) * bflo(g4v.y), bfhi(u4.y) * (e4[3] + bias) * bfhi(g4v.y));
        y.z = pk2(bflo(u4.z) * (o4[0] + bias) * bflo(g4v.z), bfhi(u4.z) * (o4[1] + bias) * bfhi(g4v.z)); y.w = pk2(bflo(u4.w) * (o4[2] + bias) * bflo(g4v.w), bfhi(u4.w) * (o4[3] + bias) * bfhi(g4v.w));
        *(v4u*)(Y + off) = y;
    }
    LBAR();
}

struct Args {
    const float* x; const float* norm_w; const float* a_w_in; const float* a_lb; const float* a_onw; const float* a_w_out;
    const float* b_w_in; const float* b_qnw; const float* b_knw; const float* b_w_out;
    const float* c_w_in; const float* c_lnw; const float* c_lnb; const float* c_ws; const float* c_bs; const float* c_w_out;
    float* out; unsigned char* ws;
};

__global__ void __launch_bounds__(NTHREADS, 2) fwd_megakernel(Args A) {
    extern __shared__ __attribute__((aligned(16))) unsigned char lds_raw[];
    LAS unsigned char* lds = (LAS unsigned char*)lds_raw;
    cg::grid_group grid = cg::this_grid();
    const int tid = threadIdx.x, lane = tid & 63, wave = __builtin_amdgcn_readfirstlane(tid >> 6);
    const int G = gridDim.x, bx = blockIdx.x;
    const int gw = bx * NWAVES + wave, NGW = G * NWAVES;
    unsigned char* ws = A.ws;
    float* ssq = (float*)(ws + WS_CTL);
    float* vs1 = ssq + 4 * MROWS; float* vs2 = vs1 + MROWS;
    bf16* WIN = (bf16*)(ws + WS_WIN); bf16* WOUT = (bf16*)(ws + WS_WOUT); bf16* XB = (bf16*)(ws + WS_XB); bf16* Y = (bf16*)(ws + WS_Y);
    bf16* PROJ = (bf16*)(ws + WS_PROJ); bf16* EXTRA = (bf16*)(ws + WS_EXTRA); float* LSE = (float*)(ws + WS_LSE);
    constexpr size_t PLANE = (size_t)MROWS * DM;
    bf16* W_BO = (bf16*)A.out + (size_t)20 * MiB; bf16* W_CI = (bf16*)A.out + (size_t)21 * MiB; bf16* W_CO = (bf16*)A.out + (size_t)24 * MiB; bf16* W_A1 = (bf16*)A.out + (size_t)25 * MiB;

    volatile LAS unsigned* xst = (volatile LAS unsigned*)(lds + LDS_BYTES - 64);
    if (tid < 16) xst[tid] = 0u;
    __syncthreads();
    const XcdBarrier xbar = xcd_barrier_post((unsigned*)(ws + WS_BAR), xst);
#define GSYNC() xcd_barrier(xbar)

    convert_weight(A.a_w_in, 1024, 4096, WIN, A.norm_w, lds, gw, NGW);
    convert_weight(A.a_w_out, 1024, 1024, WOUT, nullptr, lds, gw, NGW);
    for (int m = 2 * gw; m < MROWS; m += 2 * NGW) {
        const f32x4* xr = (const f32x4*)(A.x + (size_t)m * DM) + 2 * lane; v4u* o16 = (v4u*)(XB + (size_t)m * DM) + lane; float s0 = 0.f, s1 = 0.f;
        f32x4 va[4], vb[4];
#pragma unroll
        for (int j = 0; j < 2; ++j) { va[2 * j] = xr[128 * j]; va[2 * j + 1] = xr[128 * j + 1]; vb[2 * j] = xr[256 + 128 * j]; vb[2 * j + 1] = xr[256 + 128 * j + 1]; }
#pragma unroll
        for (int j = 0; j < 4; ++j) { s0 += (va[j][0] * va[j][0] + va[j][1] * va[j][1]) + (va[j][2] * va[j][2] + va[j][3] * va[j][3]); s1 += (vb[j][0] * vb[j][0] + vb[j][1] * vb[j][1]) + (vb[j][2] * vb[j][2] + vb[j][3] * vb[j][3]); }
#pragma unroll
        for (int j = 0; j < 2; ++j) {
            o16[64 * j] = (v4u){pk2(va[2 * j][0], va[2 * j][1]), pk2(va[2 * j][2], va[2 * j][3]), pk2(va[2 * j + 1][0], va[2 * j + 1][1]), pk2(va[2 * j + 1][2], va[2 * j + 1][3])};
            o16[128 + 64 * j] = (v4u){pk2(vb[2 * j][0], vb[2 * j][1]), pk2(vb[2 * j][2], vb[2 * j][3]), pk2(vb[2 * j + 1][0], vb[2 * j + 1][1]), pk2(vb[2 * j + 1][2], vb[2 * j + 1][3])};
        }
#pragma unroll
        for (int o = 1; o < 64; o <<= 1) { s0 += __shfl_xor(s0, o); s1 += __shfl_xor(s1, o); }
        if (lane == 0) { ssq[m] = s0; ssq[m + 1] = s1; }
    }
    for (int i = bx * NTHREADS + tid; i < 5 * MROWS; i += G * NTHREADS) ssq[MROWS + i] = 0.f;
    if (A.ws == nullptr) grid.sync();
    GSYNC();

#pragma unroll 1
    for (int rep = 0; rep < 2; ++rep) {
        const int layer = rep * 3, idx = rep;
        if (rep == 1) {
#pragma unroll 1
            for (int hb = 0; hb < 2; ++hb) {
                const int row_base = hb * 8192;
                {
                    pg8::Gemm g{XB + (size_t)row_base * DM, WIN, 8192, 10240, 1024}; pg8::StaticOrder S; S.init(8192, 10240, G, bx);
                    EpiIn<1> E{ssq + 1 * MROWS, row_base, PROJ, nullptr, nullptr, nullptr, Y, nullptr, 0, nullptr, nullptr};
                    pg8::gemm_phase<EpiIn<1>, pg8::StaticOrder, true, true>(lds, g, S, E);
                }
                GSYNC();
                bf16* OG0 = (bf16*)A.out; bf16* OG1 = (bf16*)A.out + (size_t)8192 * DM; bf16* OG2 = EXTRA;
                {
                    __syncthreads();
                    attn_phase(lds, PROJ, Y + (size_t)row_base * DM, OG0, OG1, OG2, LSE, A.b_qnw, A.b_knw, bx, G);
                }
                GSYNC();
                for (int i = bx * NTHREADS + tid; i < 8192 * 128; i += G * NTHREADS) {
                    const int row = i >> 7, o8 = i & 127, h = o8 >> 3;
                    const float l0 = LSE[((size_t)0 * 8192 + row) * 16 + h], l1 = LSE[((size_t)1 * 8192 + row) * 16 + h], l2 = LSE[((size_t)2 * 8192 + row) * 16 + h];
                    const float mx = fmaxf(l0, fmaxf(l1, l2)); const float e0 = __expf(l0 - mx), e1 = __expf(l1 - mx), e2 = __expf(l2 - mx); const float inv = 1.f / (e0 + e1 + e2);
                    const float w0 = e0 * inv, w1 = e1 * inv, w2 = e2 * inv;
                    const size_t off = (size_t)row * DM + 8 * o8;
                    const v4u a = *(const v4u*)(OG0 + off), b = *(const v4u*)(OG1 + off), c = *(const v4u*)(OG2 + off);
                    v4u o;
                    o.x = pk2(w0 * bflo(a.x) + w1 * bflo(b.x) + w2 * bflo(c.x), w0 * bfhi(a.x) + w1 * bfhi(b.x) + w2 * bfhi(c.x));
                    o.y = pk2(w0 * bflo(a.y) + w1 * bflo(b.y) + w2 * bflo(c.y), w0 * bfhi(a.y) + w1 * bfhi(b.y) + w2 * bfhi(c.y));
                    o.z = pk2(w0 * bflo(a.z) + w1 * bflo(b.z) + w2 * bflo(c.z), w0 * bfhi(a.z) + w1 * bfhi(b.z) + w2 * bfhi(c.z));
                    o.w = pk2(w0 * bflo(a.w) + w1 * bflo(b.w) + w2 * bflo(c.w), w0 * bfhi(a.w) + w1 * bfhi(b.w) + w2 * bfhi(c.w));
                    *(v4u*)(Y + (size_t)row_base * DM + off) = o;
                }
                GSYNC();
            }
            {
                pg8::Gemm g{Y, W_BO, MROWS, 1024, 1024}; pg8::StaticOrder S; S.init(MROWS, 1024, G, bx);
                EpiOut E{nullptr, nullptr, XB, ssq + 2 * MROWS};
                pg8::gemm_phase<EpiOut, pg8::StaticOrder, true, true>(lds, g, S, E);
            }
            if (DBG_STOP == 2) return;
            GSYNC();
            {
                pg8::Gemm g{XB, W_CI, MROWS, 3072, 1024}; pg8::StaticOrder S; S.init(MROWS, 3072, G, bx);
                EpiIn<2> E{ssq + 2 * MROWS, 0, PROJ, PROJ + PLANE, nullptr, nullptr, Y, nullptr, 0, vs1, vs2};
                pg8::gemm_phase<EpiIn<2>, pg8::StaticOrder, true, true>(lds, g, S, E);
            }
            GSYNC();
            {
                __syncthreads();
                if ((G & 7) == 0 && bx < 1024) gmlp_stage_w(lds, bx & 7, A.c_ws);
                for (int u = bx; u < 1024; u += G) { if ((G & 7) != 0) { gmlp_stage_w(lds, u & 7, A.c_ws); } gmlp_unit(lds, u, PROJ, PROJ + PLANE, Y, vs1, vs2, A.c_lnw, A.c_lnb, A.c_bs); }
            }
            GSYNC();
            {
                pg8::Gemm g{Y, W_CO, MROWS, 1024, 1024}; pg8::StaticOrder S; S.init(MROWS, 1024, G, bx);
                EpiOut E{nullptr, nullptr, XB, ssq + 3 * MROWS};
                pg8::gemm_phase<EpiOut, pg8::StaticOrder, true, true>(lds, g, S, E);
            }
            GSYNC();
        }
        bf16* Qb = PROJ; bf16* KKb = PROJ + PLANE; bf16* Vb = PROJ + 2 * PLANE; float* LOGF = (float*)(PROJ + 3 * PLANE);
        {
            pg8::Gemm g{XB, rep == 0 ? WIN : W_A1, MROWS, 4096, 1024}; pg8::StaticOrder S; S.init(MROWS, 4096, G, bx);
            EpiIn<0> E{ssq + (size_t)layer * MROWS, 0, Qb, KKb, Vb, LOGF, Y, A.a_lb, idx, nullptr, nullptr};
            pg8::gemm_phase<EpiIn<0>, pg8::StaticOrder, true, true>(lds, g, S, E);
            if (rep == 1) convert_weight(A.a_w_out + (size_t)1024 * 1024, 1024, 1024, WOUT, nullptr, lds, gw, NGW);
        }
        GSYNC();
        bf16* PBUF = (bf16*)A.out; float* DBUF = (float*)((bf16*)A.out + (size_t)2048 * 4096);
        hgrn_prepass(lds, Qb, KKb, LOGF, PBUF, DBUF, bx, G);
        GSYNC();
        {
            if (rep == 0) {
                const int nconv = G - 64; const int gwc = nconv > 0 ? (bx >= 64 ? (bx - 64) * NWAVES + wave : -1) : gw; const int ngwc = nconv > 0 ? nconv * NWAVES : NGW;
                convert_weight(A.b_w_in, 1024, 10240, WIN, A.norm_w + 1 * DM, lds, gwc, ngwc);
                convert_weight(A.b_w_out, 1024, 1024, W_BO, nullptr, lds, gwc, ngwc);
                convert_weight(A.c_w_in, 1024, 3072, W_CI, A.norm_w + 2 * DM, lds, gwc, ngwc);
                convert_weight(A.c_w_out, 1024, 1024, W_CO, nullptr, lds, gwc, ngwc);
                convert_weight(A.a_w_in + (size_t)1024 * 4096, 1024, 4096, W_A1, A.norm_w + 3 * DM, lds, gwc, ngwc);
            }
            __syncthreads();
            for (int u = bx; u < 64; u += G) { hgrn_unit(lds, u >> 3, u & 7, Qb, KKb, Vb, PBUF, DBUF, Y, A.a_onw + idx * 128); __syncthreads(); }
        }
        GSYNC();
        {
            pg8::Gemm g{Y, WOUT, MROWS, 1024, 1024}; pg8::StaticOrder S; S.init(MROWS, 1024, G, bx);
            EpiOut E{rep == 0 ? A.x : nullptr, rep == 0 ? nullptr : A.out, XB, rep == 0 ? ssq + 1 * MROWS : nullptr};
            pg8::gemm_phase<EpiOut, pg8::StaticOrder, true, true>(lds, g, S, E);
        }
        if (DBG_STOP == 1) return;
        if (rep == 0) GSYNC();
    }
#undef GSYNC
}

extern "C" void kernel_launch(void* const* d_in, const int* in_sizes, int n_in, void* d_out, int out_size, void* d_ws, size_t ws_size, hipStream_t stream) {
    static int grid = 0;
    if (grid == 0) {
        if (n_in != 16 || in_sizes[0] != MROWS * DM || out_size != MROWS * DM || ws_size < WS_END) { fprintf(stderr, "kernel_launch: unexpected shapes / workspace (%d inputs, ws %zu)\n", n_in, ws_size); grid = -1; return; }
        int dev = 0, cus = 0, per_cu = 0;
        if (hipGetDevice(&dev) != hipSuccess || hipDeviceGetAttribute(&cus, hipDeviceAttributeMultiprocessorCount, dev) != hipSuccess) { grid = -1; return; }
        if (hipFuncSetAttribute((const void*)fwd_megakernel, hipFuncAttributeMaxDynamicSharedMemorySize, LDS_BYTES) != hipSuccess) { fprintf(stderr, "kernel_launch: hipFuncSetAttribute failed\n"); grid = -1; return; }
        if (hipOccupancyMaxActiveBlocksPerMultiprocessor(&per_cu, (const void*)fwd_megakernel, NTHREADS, LDS_BYTES) != hipSuccess || per_cu < 1) { fprintf(stderr, "kernel_launch: occupancy query says %d\n", per_cu); per_cu = 1; }
        (void)hipGetLastError();
        grid = cus;
    }
    if (grid < 0) return;
    Args a{};
    a.x = (const float*)d_in[0]; a.norm_w = (const float*)d_in[1]; a.a_w_in = (const float*)d_in[2]; a.a_lb = (const float*)d_in[3]; a.a_onw = (const float*)d_in[4]; a.a_w_out = (const float*)d_in[5];
    a.b_w_in = (const float*)d_in[6]; a.b_qnw = (const float*)d_in[7]; a.b_knw = (const float*)d_in[8]; a.b_w_out = (const float*)d_in[9];
    a.c_w_in = (const float*)d_in[10]; a.c_lnw = (const float*)d_in[11]; a.c_lnb = (const float*)d_in[12]; a.c_ws = (const float*)d_in[13]; a.c_bs = (const float*)d_in[14]; a.c_w_out = (const float*)d_in[15];
    a.out = (float*)d_out; a.ws = (unsigned char*)d_ws;
    if (hipMemsetAsync((char*)d_ws + WS_BAR, 0, 16384, stream) != hipSuccess) { fprintf(stderr, "kernel_launch: memset failed\n"); return; }
    void* args[] = {&a};
    const hipError_t e = hipLaunchCooperativeKernel((const void*)fwd_megakernel, dim3(grid), dim3(NTHREADS), args, LDS_BYTES, stream);
    if (e != hipSuccess) fprintf(stderr, "kernel_launch: cooperative launch failed: %s (grid %d)\n", hipGetErrorString(e), grid);
}
```

```cpp
#include <hip/hip_runtime.h>
#include <hip/hip_cooperative_groups.h>
#include <cstdio>
#include <cstdint>
namespace cg = cooperative_groups;
namespace pg8 {
#define PG8_LAS __attribute__((address_space(3)))
typedef unsigned short bf16_t;
typedef short bf16x8 __attribute__((ext_vector_type(8)));
typedef float f32x4 __attribute__((ext_vector_type(4)));
typedef unsigned u32x4 __attribute__((ext_vector_type(4)));
constexpr int BM = 256, BK = 64, HALF = 128, HTB = HALF * BK * 2  , STAGE_BYTES = 8 * HTB, NXCD = 8, WGM = 8;

__host__ __device__ __forceinline__ int lds_byte(int r, int c) { const int st = (r >> 4) * 2 + (c >> 5), rr = r & 15, cc = c & 31, ob = rr * 64 + cc * 2; return st * 1024 + (ob ^ (((ob >> 9) & 1) << 5)); }
__host__ __device__ __forceinline__ void stage_rc(int b, int& R, int& C) { const int st = b / 1024, sb = b % 1024, swz = sb ^ (((sb >> 9) & 1) << 5); R = (st >> 1) * 16 + swz / 64; C = (st & 1) * 32 + (swz % 64) / 2; }
__host__ __device__ __forceinline__ int perm32(int rho) { const int n = rho >> 4, i = rho & 15; return 8 * (i >> 2) + 4 * n + (i & 3); }

struct Unit { int pm, pn; };
struct Gemm { const bf16_t* A; const bf16_t* Bt; int M, N, K; };

struct StaticOrder {
    int nM, nN, nwg, G, c;
    __host__ __device__ void init(int M, int N, int G_, int c_) { nM = M / BM; nN = N / BM; nwg = nM * nN; G = G_; c = c_; }
    __host__ __device__ bool next(int i, Unit& u) const {
        const long L = (long)i * G + c; if (L >= nwg) return false;
        int wgid = (int)L; { const int q = nwg / NXCD, r = nwg % NXCD, xcd = wgid % NXCD, off = wgid / NXCD; wgid = (xcd < r ? xcd * (q + 1) : r * (q + 1) + (xcd - r) * q) + off; }
        const int nig = WGM * nN, gid = wgid / nig, fm = gid * WGM, gsz = (nM - fm) < WGM ? (nM - fm) : WGM;
        u.pm = fm + ((wgid % nig) % gsz); u.pn = (wgid % nig) / gsz; return true;
    }
    __device__ __forceinline__ void a_ready(const Unit&) const {}
    __device__ __forceinline__ void done(const Unit&) const {}
};

__device__ __forceinline__ unsigned cvt_pk_bf16(float lo, float hi) { unsigned r; asm volatile("v_cvt_pk_bf16_f32 %0, %1, %2" : "=v"(r) : "v"(lo), "v"(hi)); return r; }
template <class Epi, class Sched, bool ALIGN_EPI = false, bool SP2 = false>
__device__ __forceinline__ void gemm_phase(PG8_LAS unsigned char* lds, const Gemm g, const Sched& S, const Epi& E) {
    int tid_l = threadIdx.x; asm volatile("" : "+v"(tid_l));
    const int tid = tid_l, wid = __builtin_amdgcn_readfirstlane(tid >> 6), lane = tid & 63, wr = wid >> 2, wc = wid & 3, fr = lane & 15, fq = lane >> 4;
    const int K = g.K, nt = K / BK;
    unsigned voffA[2], voffB[2];
#pragma unroll
    for (int i = 0; i < 2; ++i) { int R, C; stage_rc(tid * 16 + i * 8192, R, C); const int Rb = Epi::PERM ? ((R & ~31) + perm32(R & 31)) : R;
        voffA[i] = (unsigned)(R * K + C) * 2u; voffB[i] = (unsigned)(Rb * K + C) * 2u; }
    const size_t kstep = (size_t)(BK * 2);
    const size_t hstep = (size_t)HALF * K * 2;
    const size_t tstep = 2 * hstep;
    const unsigned ldsw = (unsigned)wid * 1024u;
    const int aoff = lds_byte(wr * 64 + fr, fq * 8), boff = lds_byte(wc * 32 + fr, fq * 8);
#define PG8_SA(b, h) (((b) * 2 + (h)) * HTB)
#define PG8_SB(b, h) ((4 + (b) * 2 + (h)) * HTB)
#define PG8_STAGE(bufoff, gbase, voff) do { _Pragma("unroll") for (int _i = 0; _i < 2; ++_i) \
        __builtin_amdgcn_global_load_lds((const unsigned*)((const char*)(gbase) + (voff)[_i]), (PG8_LAS unsigned*)(lds + (bufoff) + ldsw + _i * 8192), 16, 0, 0); } while (0)
#define PG8_LDA(dst, b, h) do { _Pragma("unroll") for (int m = 0; m < 4; ++m) _Pragma("unroll") for (int k = 0; k < 2; ++k) dst[m][k] = *(const PG8_LAS bf16x8*)(lds + PG8_SA(b, h) + aoff + m * 2048 + k * 1024); } while (0)
#define PG8_LDB(dst, b, h) do { _Pragma("unroll") for (int n = 0; n < 2; ++n) _Pragma("unroll") for (int k = 0; k < 2; ++k) dst[n][k] = *(const PG8_LAS bf16x8*)(lds + PG8_SB(b, h) + boff + n * 2048 + k * 1024); } while (0)
#define PG8_MMA(ai, bj, At, Bt) do { __builtin_amdgcn_s_setprio(1); _Pragma("unroll") for (int m = 0; m < 4; ++m) _Pragma("unroll") for (int n = 0; n < 2; ++n) _Pragma("unroll") for (int k = 0; k < 2; ++k) \
        acc[ai][bj][m][n] = __builtin_amdgcn_mfma_f32_16x16x32_bf16(Bt[n][k], At[m][k], acc[ai][bj][m][n], 0, 0, 0); __builtin_amdgcn_s_setprio(0); } while (0)
#define PG8_WAIT_V(n) asm volatile("s_waitcnt vmcnt(" #n ")" ::: "memory")
#define PG8_WAIT_L(n) asm volatile("s_waitcnt lgkmcnt(" #n ")" ::: "memory")
#define PG8_BAR __builtin_amdgcn_s_barrier()
#define PG8_SCHED __builtin_amdgcn_sched_barrier(0)
    Unit cur, nxt; int ui = 0;
    if (!S.next(0, cur)) return;
    f32x4 acc[2][2][4][2];
#pragma unroll
    for (int a = 0; a < 2; ++a)
#pragma unroll
        for (int b = 0; b < 2; ++b)
#pragma unroll
            for (int m = 0; m < 4; ++m)
#pragma unroll
                for (int n = 0; n < 2; ++n) acc[a][b][m][n] = (f32x4){0.f, 0.f, 0.f, 0.f};
    bf16x8 At[4][2], B0[2][2], B1[2][2];
    const char* cA = (const char*)g.A + (size_t)cur.pm * tstep; const char* cB = (const char*)g.Bt + (size_t)cur.pn * tstep;
    S.a_ready(cur);
    if constexpr (SP2) {
        PG8_STAGE(PG8_SB(0, 0), cB, voffB); PG8_STAGE(PG8_SB(0, 1), cB + hstep, voffB); PG8_STAGE(PG8_SA(0, 0), cA, voffA); PG8_STAGE(PG8_SA(0, 1), cA + hstep, voffA);
        if (wr == 1) PG8_BAR;
        PG8_WAIT_V(2); PG8_BAR;
        PG8_STAGE(PG8_SB(1, 0), cB + kstep, voffB); PG8_STAGE(PG8_SA(1, 0), cA + kstep, voffA); PG8_STAGE(PG8_SB(1, 1), cB + hstep + kstep, voffB);
        PG8_WAIT_V(6); PG8_BAR;
    } else {
        PG8_STAGE(PG8_SB(0, 0), cB, voffB); PG8_STAGE(PG8_SA(0, 0), cA, voffA); PG8_STAGE(PG8_SB(0, 1), cB + hstep, voffB); PG8_STAGE(PG8_SA(0, 1), cA + hstep, voffA);
        if (wr == 1) PG8_BAR;
        PG8_WAIT_V(4); PG8_BAR;
        PG8_STAGE(PG8_SB(1, 0), cB + kstep, voffB); PG8_STAGE(PG8_SA(1, 0), cA + kstep, voffA); PG8_STAGE(PG8_SB(1, 1), cB + hstep + kstep, voffB);
        PG8_WAIT_V(6); PG8_BAR;
    }
    for (;;) {
        const bool has_next = S.next(ui + 1, nxt);
        const char* nA = has_next ? (const char*)g.A + (size_t)nxt.pm * tstep : cA; const char* nB = has_next ? (const char*)g.Bt + (size_t)nxt.pn * tstep : cB;
        for (int t = 0; t < nt; t += 2) {
            const bool last = (t == nt - 2);
            const char* a1 = cA + (size_t)(t + 1) * kstep;
            const char* a2 = last ? nA : cA + (size_t)(t + 2) * kstep; const char* b2 = last ? nB : cB + (size_t)(t + 2) * kstep;
            const char* a3 = a2 + kstep; const char* b3 = b2 + kstep;
            if (last && has_next) S.a_ready(nxt);
            if constexpr (SP2) {
            PG8_LDB(B0, 0, 0); PG8_LDB(B1, 0, 1); PG8_SCHED; PG8_LDA(At, 0, 0); PG8_STAGE(PG8_SA(1, 1), a1 + hstep, voffA);
            PG8_WAIT_V(8); PG8_WAIT_L(0); PG8_BAR; PG8_MMA(0, 0, At, B0); PG8_MMA(0, 1, At, B1); PG8_BAR; PG8_SCHED;
            PG8_LDA(At, 0, 1); PG8_STAGE(PG8_SB(0, 0), b2, voffB); PG8_STAGE(PG8_SB(0, 1), b2 + hstep, voffB); PG8_STAGE(PG8_SA(0, 0), a2, voffA);
            PG8_WAIT_V(8); PG8_WAIT_L(0); PG8_BAR; PG8_MMA(1, 0, At, B0); PG8_MMA(1, 1, At, B1); PG8_BAR; PG8_SCHED;
            PG8_LDB(B0, 1, 0); PG8_LDB(B1, 1, 1); PG8_SCHED; PG8_LDA(At, 1, 0); PG8_STAGE(PG8_SA(0, 1), a2 + hstep, voffA);
            PG8_WAIT_V(8); PG8_WAIT_L(0); PG8_BAR; PG8_MMA(0, 0, At, B0); PG8_MMA(0, 1, At, B1); PG8_BAR; PG8_SCHED;
            PG8_LDA(At, 1, 1); PG8_STAGE(PG8_SB(1, 0), b3, voffB); PG8_STAGE(PG8_SB(1, 1), b3 + hstep, voffB); PG8_STAGE(PG8_SA(1, 0), a3, voffA);
            PG8_WAIT_V(8); PG8_WAIT_L(0); PG8_BAR; PG8_MMA(1, 0, At, B0); PG8_MMA(1, 1, At, B1); PG8_BAR; PG8_SCHED;
            } else {
            PG8_LDB(B0, 0, 0); PG8_SCHED; PG8_LDA(At, 0, 0); PG8_STAGE(PG8_SA(1, 1), a1 + hstep, voffA);
            PG8_WAIT_L(8); PG8_BAR; PG8_WAIT_L(0); PG8_MMA(0, 0, At, B0); PG8_BAR; PG8_SCHED;
            PG8_LDB(B1, 0, 1); PG8_STAGE(PG8_SB(0, 0), b2, voffB);
            PG8_BAR; PG8_WAIT_L(0); PG8_MMA(0, 1, At, B1); PG8_BAR;
            PG8_LDA(At, 0, 1); PG8_STAGE(PG8_SA(0, 0), a2, voffA);
            PG8_BAR; PG8_WAIT_L(0); PG8_MMA(1, 0, At, B0); PG8_BAR; PG8_SCHED;
            PG8_STAGE(PG8_SB(0, 1), b2 + hstep, voffB);
            PG8_WAIT_V(6); PG8_BAR; PG8_MMA(1, 1, At, B1); PG8_BAR;
            PG8_LDB(B0, 1, 0); PG8_SCHED; PG8_LDA(At, 1, 0); PG8_STAGE(PG8_SA(0, 1), a2 + hstep, voffA);
            PG8_WAIT_L(8); PG8_BAR; PG8_WAIT_L(0); PG8_MMA(0, 0, At, B0); PG8_BAR; PG8_SCHED;
            PG8_LDB(B1, 1, 1); PG8_STAGE(PG8_SB(1, 0), b3, voffB);
            PG8_BAR; PG8_WAIT_L(0); PG8_MMA(0, 1, At, B1); PG8_BAR;
            PG8_LDA(At, 1, 1); PG8_STAGE(PG8_SA(1, 0), a3, voffA);
            PG8_BAR; PG8_WAIT_L(0); PG8_MMA(1, 0, At, B0); PG8_BAR; PG8_SCHED;
            PG8_STAGE(PG8_SB(1, 1), b3 + hstep, voffB);
            PG8_WAIT_V(6); PG8_BAR; PG8_MMA(1, 1, At, B1); PG8_BAR;
            }
        }
        if constexpr (ALIGN_EPI) { if (wr == 0) PG8_BAR; }
        if constexpr (!Epi::AFTER_DRAIN) { E(acc, cur, wr, wc, fr, fq); S.done(cur); }
        if (!has_next) break;
#pragma unroll
        for (int a = 0; a < 2; ++a)
#pragma unroll
            for (int b = 0; b < 2; ++b)
#pragma unroll
                for (int m = 0; m < 4; ++m)
#pragma unroll
                    for (int n = 0; n < 2; ++n) acc[a][b][m][n] = (f32x4){0.f, 0.f, 0.f, 0.f};
        cur = nxt; cA = nA; cB = nB; ++ui;
        if constexpr (ALIGN_EPI) { if (wr == 1) PG8_BAR; }
    }
    PG8_WAIT_V(0);
    if constexpr (!ALIGN_EPI) { if (wr == 0) PG8_BAR; }
    PG8_BAR;
    if constexpr (Epi::AFTER_DRAIN) { E.fused(acc, cur, wr, wc, fr, fq, lds, wid, lane); S.done(cur); }
#undef PG8_SA
#undef PG8_SB
#undef PG8_STAGE
#undef PG8_LDA
#undef PG8_LDB
#undef PG8_MMA
#undef PG8_WAIT_V
#undef PG8_WAIT_L
#undef PG8_BAR
#undef PG8_SCHED
}
}

#define LAS __attribute__((address_space(3)))
typedef unsigned short bf16;
typedef unsigned v4u __attribute__((ext_vector_type(4)));
typedef unsigned v2u __attribute__((ext_vector_type(2)));
typedef float f32x4 __attribute__((ext_vector_type(4)));
typedef short bf16x8 __attribute__((ext_vector_type(8)));

constexpr int MROWS = 16384, DM = 1024, SEQL = 2048;
constexpr float EPS = 1e-6f;
constexpr int NTHREADS = 512, NWAVES = 8;
#ifndef DBG_NOHGRN
#define DBG_NOHGRN 0
#endif
#ifndef DBG_HG
#define DBG_HG 0
#endif
#ifndef DBG_SEG
#define DBG_SEG -1
#endif
#ifndef DBG_STOP
#define DBG_STOP 0
#endif
constexpr int LDS_BYTES = 163840;
constexpr size_t MiB = 1u << 20;
constexpr size_t WS_CTL = 0;
constexpr size_t WS_BAR = 512 * 1024;
constexpr size_t WS_WIN = 1 * MiB;
constexpr size_t WS_WOUT = 21 * MiB;
constexpr size_t WS_XB = 23 * MiB;
constexpr size_t WS_Y = 55 * MiB;
constexpr size_t WS_PROJ = 87 * MiB;
constexpr size_t WS_EXTRA = WS_PROJ + 144 * MiB;
constexpr size_t WS_LSE = 247 * MiB;
constexpr size_t WS_END = 249 * MiB;

__device__ __forceinline__ float bf2f(unsigned short u) { return __uint_as_float((unsigned)u << 16); }
__device__ __forceinline__ float bflo(unsigned u) { return __uint_as_float(u << 16); }
__device__ __forceinline__ float bfhi(unsigned u) { return __uint_as_float(u & 0xffff0000u); }
typedef float f32x2_t __attribute__((ext_vector_type(2)));
typedef __bf16 bf16x2_t __attribute__((ext_vector_type(2)));
__device__ __forceinline__ unsigned pk2(float lo, float hi) { f32x2_t v = {lo, hi}; bf16x2_t b = __builtin_convertvector(v, bf16x2_t); return __builtin_bit_cast(unsigned, b); }
__device__ __forceinline__ unsigned short f2bf(float f) { return (unsigned short)(pk2(f, 0.f) & 0xffffu); }
__device__ __forceinline__ float silu_f(float x) { return x * __builtin_amdgcn_rcpf(1.f + __expf(-x)); }
__device__ __forceinline__ float gelu_f(float x) { const float u2 = 1.5957691216057308f * (x + 0.044715f * x * x * x); return x * __builtin_amdgcn_rcpf(1.f + __expf(-u2)); }
__device__ __forceinline__ void atomic_add_agent(float* p, float v) { (void)__hip_atomic_fetch_add(p, v, __ATOMIC_RELAXED, __HIP_MEMORY_SCOPE_AGENT); }
__device__ __forceinline__ f32x4 mfma16(bf16x8 a, bf16x8 b, f32x4 c) { return __builtin_amdgcn_mfma_f32_16x16x32_bf16(a, b, c, 0, 0, 0); }

#define XB_TMO      128
#define XB_XCNT(j)  (256  + 64 * (j))
#define XB_XSUB(j)  (1280 + 64 * (j))
#define XB_XGEN(j)  (2304 + 64 * (j))
#define XB_TOP      3328
#define XB_TOPGEN   3392
#define XCD_BAR_WORDS 3456
#define XB_SPIN_CAP (1u << 18)

__device__ __forceinline__ unsigned xb_ld(unsigned* p)              { return __hip_atomic_load(p, __ATOMIC_RELAXED, __HIP_MEMORY_SCOPE_AGENT); }
__device__ __forceinline__ unsigned xb_add(unsigned* p, unsigned v) { return __hip_atomic_fetch_add(p, v, __ATOMIC_RELAXED, __HIP_MEMORY_SCOPE_AGENT); }
__device__ __forceinline__ unsigned xb_xcc_id() { return (unsigned)__builtin_amdgcn_s_getreg((3 << 11) | 20) & 0xFu; }
#define XB_SPIN(cond, bar) do { unsigned _sp = 0; while (cond) { __builtin_amdgcn_s_sleep(1); \
    if ((++_sp & 255u) == 0u) { if (xb_ld(&(bar)[XB_TMO])) break; if (_sp > XB_SPIN_CAP) { atomicAdd(&(bar)[XB_TMO], 1u); break; } } } } while (0)

struct XcdBarrier {
    unsigned* bar; unsigned x;
    volatile LAS unsigned* st;
};

__device__ __forceinline__ XcdBarrier xcd_barrier_post(unsigned* bar, volatile LAS unsigned* st) {
    XcdBarrier b; b.bar = bar; b.x = xb_xcc_id(); b.st = st;
    if (threadIdx.x == 0) (void)xb_add(&bar[XB_XCNT(b.x)], 1u);
    return b;
}
__device__ __forceinline__ void xcd_barrier_complete(unsigned* bar, unsigned x, unsigned& nloc, unsigned& nx) {
    const unsigned G = gridDim.x * gridDim.y * gridDim.z;
    unsigned sum, cnt, mine, sp = 0u;
    for (;;) {
        sum = 0u; cnt = 0u; mine = 0u;
#pragma unroll
        for (unsigned j = 0; j < 16; ++j) { const unsigned c = xb_ld(&bar[XB_XCNT(j)]); sum += c; cnt += (c > 0u) ? 1u : 0u; mine = (j == x) ? c : mine; }
        if (sum == G) break;
        __builtin_amdgcn_s_sleep(1);
        if ((++sp & 255u) == 0u) { if (xb_ld(&bar[XB_TMO])) break; if (sp > XB_SPIN_CAP) { atomicAdd(&bar[XB_TMO], 1u); break; } }
    }
    nloc = mine > 0u ? mine : 1u; nx = cnt > 0u ? cnt : 1u;
}

__device__ __forceinline__ void xcd_barrier(const XcdBarrier& b) {
    asm volatile("s_waitcnt vmcnt(0)" ::: "memory");
    __syncthreads();
    if (threadIdx.x == 0) {
        unsigned* bar = b.bar;
        __builtin_amdgcn_s_waitcnt(0);
        unsigned nloc = b.st[0], nx = b.st[1];
        if (nloc == 0u) { xcd_barrier_complete(bar, b.x, nloc, nx); b.st[0] = nloc; b.st[1] = nx; }
        const unsigned old = xb_add(&bar[XB_XSUB(b.x)], 1u);
        const unsigned gen = old / nloc;
        if (old + 1u == (gen + 1u) * nloc) {
            __builtin_amdgcn_fence(__ATOMIC_RELEASE, "agent");
            asm volatile("s_waitcnt vmcnt(0)" ::: "memory");
            const unsigned og = xb_add(&bar[XB_TOP], 1u);
            const unsigned tg = og / nx;
            if (og + 1u == (tg + 1u) * nx) xb_add(&bar[XB_TOPGEN], 1u);
            else XB_SPIN(xb_ld(&bar[XB_TOPGEN]) == tg, bar);
            __builtin_amdgcn_fence(__ATOMIC_ACQUIRE, "agent");
            xb_add(&bar[XB_XGEN(b.x)], 1u);
            asm volatile("s_waitcnt vmcnt(0)" ::: "memory");
        } else {
            XB_SPIN(xb_ld(&bar[XB_XGEN(b.x)]) == gen, bar);
            __builtin_amdgcn_fence(__ATOMIC_ACQUIRE, "agent");
            asm volatile("s_waitcnt vmcnt(0)" ::: "memory");
        }
    }
    __syncthreads();
}

__device__ __forceinline__ v4u pack8(const float (&y)[8]) { return (v4u){pk2(y[0], y[1]), pk2(y[2], y[3]), pk2(y[4], y[5]), pk2(y[6], y[7])}; }
template <int KIND> struct EpiIn {
    static constexpr bool PERM = true, AFTER_DRAIN = false;
    const float* ssq; int row_base;
    bf16* o0; bf16* o1; bf16* o2; float* of; bf16* Y;
    const float* lbsrc; int idx;
    float* vs1; float* vs2;
    __device__ __forceinline__ void operator()(const f32x4 (&acc)[2][2][4][2], const pg8::Unit& u, int wr, int wc, int fr, int fq) const {
        const int lrow0 = u.pm * 256 + wr * 64 + fr;
        const int cb = wc * 32 + 8 * fq;
        if (KIND == 0) {
            const int region = u.pn >> 2; const int c0 = (u.pn & 3) * 256 + cb;
            float rs[2][4];
#pragma unroll
            for (int ai = 0; ai < 2; ++ai)
#pragma unroll
                for (int m = 0; m < 4; ++m) rs[ai][m] = rsqrtf(ssq[lrow0 + ai * 128 + m * 16] * (1.f / 1024.f) + EPS);
#pragma unroll
            for (int bj = 0; bj < 2; ++bj) {
                const int c = c0 + bj * 128;
                float lb[8] = {0.f, 0.f, 0.f, 0.f, 0.f, 0.f, 0.f, 0.f};
                if (region == 1 && idx != 0) {
                    const f32x4 a00 = *(const f32x4*)(lbsrc + c), a01 = *(const f32x4*)(lbsrc + c + 4), a10 = *(const f32x4*)(lbsrc + 1024 + c), a11 = *(const f32x4*)(lbsrc + 1024 + c + 4);
#pragma unroll
                    for (int j = 0; j < 4; ++j) { lb[j] = __builtin_amdgcn_rcpf(1.f + __expf(a00[j] - a10[j])); lb[4 + j] = __builtin_amdgcn_rcpf(1.f + __expf(a01[j] - a11[j])); }
                }
#pragma unroll
                for (int ai = 0; ai < 2; ++ai)
#pragma unroll
                    for (int m = 0; m < 4; ++m) {
                        const int row = lrow0 + ai * 128 + m * 16; const size_t off = (size_t)row * 1024 + c;
                        const f32x4 v0 = acc[ai][bj][m][0] * rs[ai][m], v1 = acc[ai][bj][m][1] * rs[ai][m];
                        const float v[8] = {v0[0], v0[1], v0[2], v0[3], v1[0], v1[1], v1[2], v1[3]};
                        float y[8];
                        if (region == 0) {
#pragma unroll
                            for (int j = 0; j < 8; ++j) y[j] = silu_f(v[j]);
                            *(v4u*)(o0 + off) = pack8(y);
                        } else if (region == 1) {
                            float lf[8];
#pragma unroll
                            for (int j = 0; j < 8; ++j) {
                                const float om = 1.f - lb[j];
                                const float fc = fminf(fmaxf(v[j], -80.f), 80.f);
                                const float e = __expf(-fc), sg = __builtin_amdgcn_rcpf(1.f + e);
                                y[j] = om * e * sg;
                                lf[j] = __logf(fmaxf(lb[j] + om * sg, 1e-30f));
                            }
                            *(v4u*)(o1 + off) = pack8(y);
                            *(f32x4*)(of + off) = (f32x4){lf[0], lf[1], lf[2], lf[3]}; *(f32x4*)(of + off + 4) = (f32x4){lf[4], lf[5], lf[6], lf[7]};
                        } else if (region == 2) { *(v4u*)(o2 + off) = pack8(v); }
                        else {
#pragma unroll
                            for (int j = 0; j < 8; ++j) y[j] = silu_f(v[j]);
                            *(v4u*)(Y + off) = pack8(y);
                        }
                    }
            }
        } else if (KIND == 1) {
            const bool gate = (u.pn >= 36);
#pragma unroll
            for (int ai = 0; ai < 2; ++ai)
#pragma unroll
                for (int m = 0; m < 4; ++m) {
                    const int lrow = lrow0 + ai * 128 + m * 16; const int row = row_base + lrow;
                    const float rs = rsqrtf(ssq[row] * (1.f / 1024.f) + EPS);
#pragma unroll
                    for (int bj = 0; bj < 2; ++bj) {
                        const int c = cb + bj * 128;
                        const f32x4 v0 = acc[ai][bj][m][0] * rs, v1 = acc[ai][bj][m][1] * rs;
                        const float v[8] = {v0[0], v0[1], v0[2], v0[3], v1[0], v1[1], v1[2], v1[3]};
                        if (!gate) *(v4u*)(o0 + (size_t)lrow * 9216 + u.pn * 256 + c) = pack8(v);
                        else { float y[8];
#pragma unroll
                            for (int j = 0; j < 8; ++j) y[j] = silu_f(v[j]);
                            *(v4u*)(Y + (size_t)row * 1024 + (u.pn - 36) * 256 + c) = pack8(y); }
                    }
                }
        } else {
            const int region = u.pn >> 2; const int c0 = (u.pn & 3) * 256 + cb;
#pragma unroll
            for (int ai = 0; ai < 2; ++ai)
#pragma unroll
                for (int m = 0; m < 4; ++m) {
                    const int row = lrow0 + ai * 128 + m * 16;
                    const float rs = rsqrtf(ssq[row] * (1.f / 1024.f) + EPS);
                    float s1 = 0.f, s2 = 0.f;
#pragma unroll
                    for (int bj = 0; bj < 2; ++bj) {
                        const int c = c0 + bj * 128; const size_t off = (size_t)row * 1024 + c;
                        const f32x4 v0 = acc[ai][bj][m][0] * rs, v1 = acc[ai][bj][m][1] * rs;
                        const float v[8] = {v0[0], v0[1], v0[2], v0[3], v1[0], v1[1], v1[2], v1[3]};
                        float y[8];
                        if (region == 0) {
#pragma unroll
                            for (int j = 0; j < 8; ++j) y[j] = gelu_f(v[j]);
                            *(v4u*)(o0 + off) = pack8(y);
                        } else if (region == 1) {
#pragma unroll
                            for (int j = 0; j < 8; ++j) { y[j] = gelu_f(v[j]); s1 += y[j]; s2 += y[j] * y[j]; }
                            *(v4u*)(o1 + off) = pack8(y);
                        } else {
#pragma unroll
                            for (int j = 0; j < 8; ++j) y[j] = silu_f(v[j]);
                            *(v4u*)(Y + off) = pack8(y);
                        }
                    }
                    if (region == 1) {
                        s1 += __shfl_xor(s1, 16); s1 += __shfl_xor(s1, 32); s2 += __shfl_xor(s2, 16); s2 += __shfl_xor(s2, 32);
                        if (fq == 0) { atomic_add_agent(vs1 + row, s1); atomic_add_agent(vs2 + row, s2); }
                    }
                }
        }
    }
};

struct EpiOut {
    static constexpr bool PERM = true, AFTER_DRAIN = false;
    const float* xin; float* xout; bf16* xb; float* ssq;
    __device__ __forceinline__ void operator()(const f32x4 (&acc)[2][2][4][2], const pg8::Unit& u, int wr, int wc, int fr, int fq) const {
        const int row0 = u.pm * 256 + wr * 64 + fr; const int c0 = u.pn * 256 + wc * 32 + 8 * fq;
#pragma unroll
        for (int ai = 0; ai < 2; ++ai)
#pragma unroll
            for (int m = 0; m < 4; ++m) {
                const int row = row0 + ai * 128 + m * 16; float s2 = 0.f;
#pragma unroll
                for (int bj = 0; bj < 2; ++bj) {
                    const size_t off = (size_t)row * 1024 + c0 + bj * 128;
                    f32x4 x0, x1;
                    if (xin) { x0 = *(const f32x4*)(xin + off); x1 = *(const f32x4*)(xin + off + 4); }
                    else { const v4u xv = *(const v4u*)(xb + off); x0 = (f32x4){bflo(xv.x), bfhi(xv.x), bflo(xv.y), bfhi(xv.y)}; x1 = (f32x4){bflo(xv.z), bfhi(xv.z), bflo(xv.w), bfhi(xv.w)}; }
                    const f32x4 n0 = x0 + acc[ai][bj][m][0], n1 = x1 + acc[ai][bj][m][1];
                    if (xout) { *(f32x4*)(xout + off) = n0; *(f32x4*)(xout + off + 4) = n1; }
                    else *(v4u*)(xb + off) = (v4u){pk2(n0[0], n0[1]), pk2(n0[2], n0[3]), pk2(n1[0], n1[1]), pk2(n1[2], n1[3])};
                    s2 += ((n0[0] * n0[0] + n0[1] * n0[1]) + (n0[2] * n0[2] + n0[3] * n0[3])) + ((n1[0] * n1[0] + n1[1] * n1[1]) + (n1[2] * n1[2] + n1[3] * n1[3]));
                }
                if (ssq) { s2 += __shfl_xor(s2, 16); s2 += __shfl_xor(s2, 32); if (fq == 0) atomic_add_agent(ssq + row, s2); }
            }
    }
};

__device__ __forceinline__ void transpose_item(const float* W, int K, int N, bf16* WT, const float* scale, LAS float* scr, int item, int lane) {
    const int nblk = N / 32, kb = item / nblk, nb = item % nblk, k0 = 64 * kb, n0 = 32 * nb;
    {
        const int q = lane & 7, r = lane >> 3;
        f32x4 v[8];
#pragma unroll
        for (int i = 0; i < 8; ++i) v[i] = *(const f32x4*)(W + (size_t)(k0 + 8 * i + r) * N + n0 + 4 * q);
#pragma unroll
        for (int i = 0; i < 8; ++i) { const int kk = 8 * i + r; f32x4 x = v[i]; if (scale) x = x * scale[k0 + kk];
            scr[kk * 33 + 4 * q + 0] = x[0]; scr[kk * 33 + 4 * q + 1] = x[1]; scr[kk * 33 + 4 * q + 2] = x[2]; scr[kk * 33 + 4 * q + 3] = x[3]; }
    }
    asm volatile("s_waitcnt lgkmcnt(0)" ::: "memory");
    const int c = lane & 7;
#pragma unroll
    for (int j = 0; j < 4; ++j) { const int n = (lane >> 3) + 8 * j; const LAS float* s = scr + (8 * c) * 33 + n;
        v4u o; o.x = pk2(s[0 * 33], s[1 * 33]); o.y = pk2(s[2 * 33], s[3 * 33]); o.z = pk2(s[4 * 33], s[5 * 33]); o.w = pk2(s[6 * 33], s[7 * 33]);
        *(v4u*)(WT + (size_t)(n0 + n) * K + k0 + 8 * c) = o; }
    asm volatile("s_waitcnt lgkmcnt(0)" ::: "memory");
}
__device__ __forceinline__ void convert_weight(const float* W, int K, int N, bf16* WT, const float* scale, LAS unsigned char* lds, int gw, int ngw) {
    if (gw < 0) return;
    int tid_l = threadIdx.x; asm volatile("" : "+v"(tid_l));
    const int lane = tid_l & 63, wave = __builtin_amdgcn_readfirstlane(tid_l >> 6);
    LAS float* scr = (LAS float*)(lds + wave * 16384);
    const int nitems = (K / 64) * (N / 32);
    for (int it = gw; it < nitems; it += ngw) transpose_item(W, K, N, WT, scale, scr, it, lane);
}

typedef short v4i16_t __attribute__((ext_vector_type(4)));
#define LBAR() do { asm volatile("s_waitcnt lgkmcnt(0)" ::: "memory"); __builtin_amdgcn_s_barrier(); asm volatile("" ::: "memory"); } while (0)
__device__ __forceinline__ bf16x8 tr_frag(const LAS bf16* img, int stride, int k0, int n0, int l16, int g4) {
    const LAS bf16* a = img + (k0 + 8 * g4 + (l16 >> 2)) * stride + n0 + 4 * (l16 & 3);
    const v4i16_t lo = __builtin_amdgcn_ds_read_tr16_b64_v4i16((LAS v4i16_t*)a);
    const v4i16_t hi = __builtin_amdgcn_ds_read_tr16_b64_v4i16((LAS v4i16_t*)(a + 4 * stride));
    return (bf16x8){lo[0], lo[1], lo[2], lo[3], hi[0], hi[1], hi[2], hi[3]};
}

constexpr int PP_QT = 0;
constexpr int PP_KT = PP_QT + 64 * 272;
constexpr int PP_K2 = PP_KT + 64 * 272;
constexpr int PP_QX = PP_K2 + 64 * 272;
constexpr int PP_DEC = PP_QX + 48 * 272;
static_assert(PP_DEC + 2048 <= 131072, "prepass lds");
__device__ __forceinline__ void hgrn_prepass(LAS unsigned char* lds, bf16* Q, bf16* KK, const float* LOGF, bf16* PBUF, float* DBUF, int bx, int G) {
    int tid_l = threadIdx.x; asm volatile("" : "+v"(tid_l));
    const int tid = tid_l, lane = tid & 63, w = __builtin_amdgcn_readfirstlane(tid >> 6), l16 = lane & 15, g4 = lane >> 4;
    LAS bf16* Qt = (LAS bf16*)(lds + PP_QT); LAS bf16* Kt = (LAS bf16*)(lds + PP_KT); LAS bf16* K2 = (LAS bf16*)(lds + PP_K2); LAS bf16* QX = (LAS bf16*)(lds + PP_QX); LAS float* DEC = (LAS float*)(lds + PP_DEC);
    const int pk = tid & 127, pi = tid >> 7;
    float lfr[16]; unsigned qr[16], kr[16];
#define PP_LOAD(uu) do { const int c_ = (uu) & 31, bh_ = (uu) >> 5; const size_t rb_ = ((size_t)(bh_ >> 3) * SEQL + 64 * c_ + 16 * pi) * 1024 + (size_t)(bh_ & 7) * 128 + pk; \
        _Pragma("unroll") for (int j = 0; j < 16; ++j) { const size_t a_ = rb_ + (size_t)j * 1024; lfr[j] = LOGF[a_]; qr[j] = Q[a_]; kr[j] = KK[a_]; } } while (0)
    int u = bx;
    if (u < 2048) PP_LOAD(u);
#pragma unroll 1
    for (; u < 2048; u += G) {
        const int c = u & 31, bh = u >> 5; const size_t m0 = (size_t)(bh >> 3) * SEQL + 64 * c; const int hc = (bh & 7) * 128;
        {
            float bl[16], kkv[16]; float bsum = 0.f;
#pragma unroll
            for (int j = 0; j < 16; ++j) {
                const float q = bf2f((unsigned short)qr[j]); const float kk = bf2f((unsigned short)kr[j]);
                bsum += lfr[j]; bl[j] = bsum; kkv[j] = kk;
                Qt[(16 * pi + j) * 136 + pk] = f2bf(q * __expf(bsum));
                Kt[(16 * pi + j) * 136 + pk] = f2bf(kk * __expf(fminf(-bsum, 80.f)));
            }
            DEC[pi * 128 + pk] = __expf(bsum);
#pragma unroll
            for (int j = 0; j < 16; ++j) K2[(16 * pi + j) * 136 + pk] = f2bf(kkv[j] * __expf(bsum - bl[j]));
        }
        if (u + G < 2048) PP_LOAD(u + G);
        LBAR();
        {
            const float d0 = DEC[pk], d1 = DEC[128 + pk], d2 = DEC[256 + pk], d3 = DEC[384 + pk];
            const float eq = pi == 0 ? 1.f : (pi == 1 ? d0 : (pi == 2 ? d0 * d1 : d0 * d1 * d2));
            const float gk = pi == 3 ? 1.f : (pi == 2 ? d3 : (pi == 1 ? d2 * d3 : d1 * d2 * d3));
            const size_t gb = (m0 + 16 * pi) * 1024 + hc + pk;
#pragma unroll
            for (int j = 0; j < 16; ++j) {
                const float qt = bf2f(Qt[(16 * pi + j) * 136 + pk]), k2 = bf2f(K2[(16 * pi + j) * 136 + pk]);
                Q[gb + (size_t)j * 1024] = f2bf(qt * eq); KK[gb + (size_t)j * 1024] = f2bf(k2 * gk);
            }
#pragma unroll
            for (int jj = 0; jj < 12; ++jj) {
                const int r = 12 * pi + jj, tile = r >> 4, rr = r & 15;
                const float f = tile == 0 ? d1 : (tile == 1 ? d2 : d1 * d2);
                QX[r * 136 + pk] = f2bf(bf2f(Qt[((tile == 0 ? 32 : 48) + rr) * 136 + pk]) * f);
            }
            if (pi == 0) DBUF[(size_t)u * 128 + pk] = (d0 * d1) * (d2 * d3);
        }
        LBAR();
#pragma unroll 1
        for (int job = w; job < 12; job += 8) {
            int bi, bj; const LAS bf16* Ab; const LAS bf16* Bb; bool diag = false, zero = false;
            if (job < 4) { bi = job; bj = job; Ab = Kt + 16 * bj * 136; Bb = Qt + 16 * bi * 136; diag = true; }
            else if (job < 7) { bi = job - 3; bj = job - 4; Ab = K2 + 16 * bj * 136; Bb = Qt + 16 * bi * 136; }
            else if (job == 7) { bi = 2; bj = 0; Ab = K2; Bb = QX; }
            else if (job == 8) { bi = 3; bj = 1; Ab = K2 + 16 * 136; Bb = QX + 16 * 136; }
            else if (job == 9) { bi = 3; bj = 0; Ab = K2; Bb = QX + 32 * 136; }
            else if (job == 10) { bi = 0; bj = 1; Ab = Kt; Bb = Qt; zero = true; }
            else { bi = 2; bj = 3; Ab = Kt; Bb = Qt; zero = true; }
            f32x4 a4 = (f32x4){0.f, 0.f, 0.f, 0.f};
            if (!zero) {
#pragma unroll
                for (int ks = 0; ks < 4; ++ks) {
                    const bf16x8 a = *(const LAS bf16x8*)(Ab + l16 * 136 + 32 * ks + 8 * g4);
                    const bf16x8 bq = *(const LAS bf16x8*)(Bb + l16 * 136 + 32 * ks + 8 * g4);
                    a4 = mfma16(a, bq, a4);
                }
            }
            float pv[4];
#pragma unroll
            for (int r = 0; r < 4; ++r) pv[r] = (!diag || (4 * g4 + r <= l16)) ? a4[r] : 0.f;
            *(v2u*)(PBUF + (size_t)u * 4096 + (16 * bi + l16) * 64 + 16 * bj + 4 * g4) = (v2u){pk2(pv[0], pv[1]), pk2(pv[2], pv[3])};
        }
        LBAR();
    }
#undef PP_LOAD
}

constexpr int HS_QT = 0;
constexpr int HS_K2 = HS_QT + 64 * 272;
constexpr int HS_VR = HS_K2 + 64 * 272;
constexpr int HS_P = HS_VR + 64 * 272;
constexpr int HS_DEC = HS_P + 64 * 144;
constexpr int HS_SET = HS_DEC + 512;
constexpr int H_SSQ = 2 * HS_SET;
constexpr int H_OB = H_SSQ + 4096;
constexpr int H_END = H_OB + 2 * 64 * 272;
static_assert(H_END <= LDS_BYTES - 64 && (HS_SET % 16) == 0, "hgrn lds");
__device__ __forceinline__ v4u tr_pair(const LAS bf16* a, int stride4) {
    const v4i16_t lo = __builtin_amdgcn_ds_read_tr16_b64_v4i16((LAS v4i16_t*)a);
    const v4i16_t hi = __builtin_amdgcn_ds_read_tr16_b64_v4i16((LAS v4i16_t*)(a + stride4));
    const v2u l2 = __builtin_bit_cast(v2u, lo), h2 = __builtin_bit_cast(v2u, hi);
    return (v4u){l2.x, l2.y, h2.x, h2.y};
}
__device__ __forceinline__ void hgrn_unit(LAS unsigned char* lds, int b, int h, const bf16* Q, const bf16* KK, const bf16* V, const bf16* PBUF, const float* DBUF, bf16* Y, const float* onw) {
    int tid_l = threadIdx.x; asm volatile("" : "+v"(tid_l));
    const int tid = tid_l, lane = tid & 63, w = __builtin_amdgcn_readfirstlane(tid >> 6), l16 = lane & 15, g4 = lane >> 4;
    const bool cw = (w < 4);
    const int ubase = (b * 8 + h) * 32;
    if (!cw) {
        const int lt = tid - 256;
        v4u lqA[4], lkA[4], lvA[4], lpA[2], ldA;
#define LD_ISSUE(cc, lq, lk, lv, lp, ld) do { const size_t mb_ = (size_t)b * SEQL + 64 * (cc); \
            _Pragma("unroll") for (int jj = 0; jj < 4; ++jj) { const int id_ = lt + 256 * jj; const size_t o_ = (mb_ + (id_ >> 4)) * 1024 + (size_t)h * 128 + 8 * (id_ & 15); \
                lq[jj] = *(const v4u*)(Q + o_); lk[jj] = *(const v4u*)(KK + o_); lv[jj] = *(const v4u*)(V + o_); } \
            _Pragma("unroll") for (int jj = 0; jj < 2; ++jj) lp[jj] = *(const v4u*)(PBUF + (size_t)(ubase + (cc)) * 4096 + 8 * (lt + 256 * jj)); \
            ld = (v4u){0u, 0u, 0u, 0u}; if (lt < 32) ld = *(const v4u*)(DBUF + (size_t)(ubase + (cc)) * 128 + 4 * lt); } while (0)
#define LD_WRITE(set, lq, lk, lv, lp, ld) do { LAS unsigned char* sb_ = lds + (set) * HS_SET; \
            _Pragma("unroll") for (int jj = 0; jj < 4; ++jj) { const int id_ = lt + 256 * jj; const int e_ = (id_ >> 4) * 136 + 8 * (id_ & 15); \
                *(LAS v4u*)((LAS bf16*)(sb_ + HS_QT) + e_) = lq[jj]; *(LAS v4u*)((LAS bf16*)(sb_ + HS_K2) + e_) = lk[jj]; *(LAS v4u*)((LAS bf16*)(sb_ + HS_VR) + e_) = lv[jj]; } \
            _Pragma("unroll") for (int jj = 0; jj < 2; ++jj) { const int id_ = lt + 256 * jj; *(LAS v4u*)((LAS bf16*)(sb_ + HS_P) + (id_ >> 3) * 72 + 8 * (id_ & 7)) = lp[jj]; } \
            if (lt < 32) *(LAS v4u*)((LAS float*)(sb_ + HS_DEC) + 4 * lt) = ld; } while (0)
        const int foct = lt & 15;
        const f32x4 fw0 = *(const f32x4*)(onw + 8 * foct), fw1 = *(const f32x4*)(onw + 8 * foct + 4);
        v4u gt[4];
#define GATE_LOAD(cc) do { _Pragma("unroll") for (int jj = 0; jj < 4; ++jj) gt[jj] = *(const v4u*)(Y + ((size_t)b * SEQL + 64 * (cc) + ((lt + 256 * jj) >> 4)) * 1024 + (size_t)h * 128 + 8 * foct); } while (0)
#define FINISH(cc) do { const LAS float* sq_ = (const LAS float*)(lds + H_SSQ) + ((cc) & 1) * 512; const LAS bf16* ob_ = (const LAS bf16*)(lds + H_OB) + ((cc) & 1) * (64 * 136); \
            _Pragma("unroll") for (int jj = 0; jj < 4; ++jj) { const int t_ = (lt + 256 * jj) >> 4; \
                const f32x4 s0_ = *(const LAS f32x4*)(sq_ + t_ * 8), s1_ = *(const LAS f32x4*)(sq_ + t_ * 8 + 4); \
                const float rs_ = rsqrtf((((s0_[0] + s0_[1]) + (s0_[2] + s0_[3])) + ((s1_[0] + s1_[1]) + (s1_[2] + s1_[3]))) * (1.f / 128.f) + EPS); \
                const v4u o_ = *(const LAS v4u*)(ob_ + t_ * 136 + 8 * foct); const v4u g_ = gt[jj]; v4u y_; \
                y_.x = pk2(bflo(o_.x) * rs_ * fw0[0] * bflo(g_.x), bfhi(o_.x) * rs_ * fw0[1] * bfhi(g_.x)); y_.y = pk2(bflo(o_.y) * rs_ * fw0[2] * bflo(g_.y), bfhi(o_.y) * rs_ * fw0[3] * bfhi(g_.y)); \
                y_.z = pk2(bflo(o_.z) * rs_ * fw1[0] * bflo(g_.z), bfhi(o_.z) * rs_ * fw1[1] * bfhi(g_.z)); y_.w = pk2(bflo(o_.w) * rs_ * fw1[2] * bflo(g_.w), bfhi(o_.w) * rs_ * fw1[3] * bfhi(g_.w)); \
                *(v4u*)(Y + ((size_t)b * SEQL + 64 * (cc) + t_) * 1024 + (size_t)h * 128 + 8 * foct) = y_; } } while (0)
        LD_ISSUE(0, lqA, lkA, lvA, lpA, ldA);
        LD_WRITE(0, lqA, lkA, lvA, lpA, ldA); LD_ISSUE(1, lqA, lkA, lvA, lpA, ldA);
        GATE_LOAD(0);
        LBAR();
#pragma unroll 1
        for (int c = 0; c < 32; ++c) {
            if (c > 0) { FINISH(c - 1); GATE_LOAD(c); }
            if (c + 1 < 32) { LD_WRITE((c + 1) & 1, lqA, lkA, lvA, lpA, ldA); if (c + 2 < 32) LD_ISSUE(c + 2, lqA, lkA, lvA, lpA, ldA); }
            LBAR();
        }
        FINISH(31);
#undef GATE_LOAD
#undef FINISH
#undef LD_ISSUE
#undef LD_WRITE
        return;
    }
    const int wt = 2 * w;
    __builtin_amdgcn_s_setprio(2);
    LAS float* SSQ = (LAS float*)(lds + H_SSQ);
    f32x4 sacc0[8], sacc1[8];
#pragma unroll
    for (int i = 0; i < 8; ++i) { sacc0[i] = (f32x4){0.f, 0.f, 0.f, 0.f}; sacc1[i] = (f32x4){0.f, 0.f, 0.f, 0.f}; }
    const int qoff = l16 * 136 + 4 * g4;
    const int voff = (8 * g4 + (l16 >> 2)) * 136 + 16 * wt + 4 * (l16 & 3);
    const int koff = (8 * g4 + (l16 >> 2)) * 136 + 4 * (l16 & 3);
    const int poff = l16 * 72 + 8 * g4;
    LBAR();
#pragma unroll 1
    for (int c = 0; c < 32; ++c) {
        const size_t m0 = (size_t)b * SEQL + 64 * c;
        LAS unsigned char* sb = lds + (c & 1) * HS_SET;
        const LAS bf16* qbase = (const LAS bf16*)(sb + HS_QT) + qoff; const LAS bf16* vbase = (const LAS bf16*)(sb + HS_VR) + voff; const LAS bf16* kbase = (const LAS bf16*)(sb + HS_K2) + koff;
        const LAS bf16* pbase = (const LAS bf16*)(sb + HS_P) + poff; const LAS float* dbase = (const LAS float*)(sb + HS_DEC) + 4 * g4;
        LAS float* sqw = SSQ + (c & 1) * 512;
        LAS bf16* obw = (LAS bf16*)(lds + H_OB) + (c & 1) * (64 * 136) + l16 * 136 + 16 * wt + 4 * g4;
        v4u a0[4], a1[4];
#pragma unroll
        for (int kp = 0; kp < 4; ++kp) {
            a0[kp] = (v4u){pk2(sacc0[2 * kp][0], sacc0[2 * kp][1]), pk2(sacc0[2 * kp][2], sacc0[2 * kp][3]), pk2(sacc0[2 * kp + 1][0], sacc0[2 * kp + 1][1]), pk2(sacc0[2 * kp + 1][2], sacc0[2 * kp + 1][3])};
            a1[kp] = (v4u){pk2(sacc1[2 * kp][0], sacc1[2 * kp][1]), pk2(sacc1[2 * kp][2], sacc1[2 * kp][3]), pk2(sacc1[2 * kp + 1][0], sacc1[2 * kp + 1][1]), pk2(sacc1[2 * kp + 1][2], sacc1[2 * kp + 1][3])};
        }
        v4u av0[2], av1[2];
#pragma unroll
        for (int ks = 0; ks < 2; ++ks) { av0[ks] = tr_pair(vbase + 32 * ks * 136, 4 * 136); av1[ks] = tr_pair(vbase + 32 * ks * 136 + 16, 4 * 136); }
#pragma unroll
        for (int ti = 0; ti < 4; ++ti) {
            v2u qf[8]; v4u pf[2];
#pragma unroll
            for (int kp = 0; kp < 4; ++kp) { qf[2 * kp] = *(const LAS v2u*)(qbase + 16 * ti * 136 + 32 * kp); qf[2 * kp + 1] = *(const LAS v2u*)(qbase + 16 * ti * 136 + 32 * kp + 16); }
            pf[0] = *(const LAS v4u*)(pbase + 16 * ti * 72); pf[1] = *(const LAS v4u*)(pbase + 16 * ti * 72 + 32);
            __builtin_amdgcn_sched_barrier(0);
            f32x4 o0 = (f32x4){0.f, 0.f, 0.f, 0.f}, o1 = o0;
#pragma unroll
            for (int kp = 0; kp < 4; ++kp) {
                const bf16x8 bq = __builtin_bit_cast(bf16x8, ((v4u){qf[2 * kp].x, qf[2 * kp].y, qf[2 * kp + 1].x, qf[2 * kp + 1].y}));
                o0 = mfma16(__builtin_bit_cast(bf16x8, a0[kp]), bq, o0); o1 = mfma16(__builtin_bit_cast(bf16x8, a1[kp]), bq, o1);
            }
            o0 = mfma16(__builtin_bit_cast(bf16x8, av0[0]), __builtin_bit_cast(bf16x8, pf[0]), o0); o1 = mfma16(__builtin_bit_cast(bf16x8, av1[0]), __builtin_bit_cast(bf16x8, pf[0]), o1);
            if (ti >= 2) { o0 = mfma16(__builtin_bit_cast(bf16x8, av0[1]), __builtin_bit_cast(bf16x8, pf[1]), o0); o1 = mfma16(__builtin_bit_cast(bf16x8, av1[1]), __builtin_bit_cast(bf16x8, pf[1]), o1); }
            {
                float sa = (o0[0] * o0[0] + o0[1] * o0[1]) + (o0[2] * o0[2] + o0[3] * o0[3]), sb2 = (o1[0] * o1[0] + o1[1] * o1[1]) + (o1[2] * o1[2] + o1[3] * o1[3]);
                sa += __shfl_xor(sa, 16); sa += __shfl_xor(sa, 32); sb2 += __shfl_xor(sb2, 16); sb2 += __shfl_xor(sb2, 32);
                if (g4 == 0) { sqw[(16 * ti + l16) * 8 + wt] = sa; sqw[(16 * ti + l16) * 8 + wt + 1] = sb2; }
                *(LAS v2u*)(obw + 16 * ti * 136) = (v2u){pk2(o0[0], o0[1]), pk2(o0[2], o0[3])}; *(LAS v2u*)(obw + 16 * ti * 136 + 16) = (v2u){pk2(o1[0], o1[1]), pk2(o1[2], o1[3])};
            }
        }
#pragma unroll
        for (int kh = 0; kh < 2; ++kh) {
            v4u ak[4][2]; f32x4 dch[4];
#pragma unroll
            for (int kt = 0; kt < 4; ++kt) { ak[kt][0] = tr_pair(kbase + 16 * (4 * kh + kt), 4 * 136); ak[kt][1] = tr_pair(kbase + 32 * 136 + 16 * (4 * kh + kt), 4 * 136); dch[kt] = *(const LAS f32x4*)(dbase + 16 * (4 * kh + kt)); }
            __builtin_amdgcn_sched_barrier(0);
#pragma unroll
            for (int kt = 0; kt < 4; ++kt) {
                const int k8 = 4 * kh + kt;
                sacc0[k8] = mfma16(__builtin_bit_cast(bf16x8, ak[kt][0]), __builtin_bit_cast(bf16x8, av0[0]), sacc0[k8] * dch[kt]); sacc1[k8] = mfma16(__builtin_bit_cast(bf16x8, ak[kt][0]), __builtin_bit_cast(bf16x8, av1[0]), sacc1[k8] * dch[kt]);
                sacc0[k8] = mfma16(__builtin_bit_cast(bf16x8, ak[kt][1]), __builtin_bit_cast(bf16x8, av0[1]), sacc0[k8]); sacc1[k8] = mfma16(__builtin_bit_cast(bf16x8, ak[kt][1]), __builtin_bit_cast(bf16x8, av1[1]), sacc1[k8]);
            }
        }
        LBAR();
    }
    __builtin_amdgcn_s_setprio(0);
}

constexpr int AT_KS = 0;
constexpr int AT_VS = 256 * 144;
constexpr int AT_END = AT_VS + 256 * 160;
static_assert(AT_END <= 131072, "attn lds");

__device__ __forceinline__ void attn_phase(LAS unsigned char* lds, const bf16* PROJ, const bf16* Ygate, bf16* OG0, bf16* OG1, bf16* OG2, float* LSE, const float* qnw, const float* knw, int bx, int G) {
    int tid_l = threadIdx.x; asm volatile("" : "+v"(tid_l));
    const int tid = tid_l, lane = tid & 63, w = __builtin_amdgcn_readfirstlane(tid >> 6), l16 = lane & 15, g4 = lane >> 4;
    LAS bf16* Ks = (LAS bf16*)(lds + AT_KS); LAS bf16* Vs = (LAS bf16*)(lds + AT_VS);
    const int oct = tid & 7;
    v4u kr[4], vr[4], qr[2];
#define AT_LOAD(tt) do { const int sub_ = (tt) & 15, gi_ = ((tt) >> 4) % 3, bh_ = (tt) / 48, h_ = bh_ & 15, bl_ = bh_ >> 4; \
        const int sh_ = 2 * gi_, d_ = 1 << sh_, r_ = sub_ & (d_ - 1), n_ = sub_ >> sh_; const int colq_ = gi_ * 3072 + h_ * 64; \
        _Pragma("unroll") for (int jj = 0; jj < 4; ++jj) { const int key_ = (tid >> 3) + 64 * jj; const int p_ = 128 * (n_ - 1) + key_; \
            kr[jj] = (v4u){0u, 0u, 0u, 0u}; vr[jj] = (v4u){0u, 0u, 0u, 0u}; \
            if (p_ >= 0) { const size_t row_ = (size_t)bl_ * SEQL + (size_t)p_ * d_ + r_; kr[jj] = *(const v4u*)(PROJ + row_ * 9216 + colq_ + 1024 + 8 * oct); vr[jj] = *(const v4u*)(PROJ + row_ * 9216 + colq_ + 2048 + 8 * oct); } } \
        { const size_t qrow_ = (size_t)bl_ * SEQL + (size_t)(128 * n_ + 16 * w + l16) * d_ + r_; \
          _Pragma("unroll") for (int ks = 0; ks < 2; ++ks) qr[ks] = *(const v4u*)(PROJ + qrow_ * 9216 + colq_ + 32 * ks + 8 * g4); } } while (0)
    const bool swz = (G == 256);
#define AT_TASK(j) (swz ? ((bx & 7) * 384 + (j) * 32 + (bx >> 3)) : (bx + (j) * G))
    int jn = 0;
    if (bx < 3072) { const int t0_ = AT_TASK(0); AT_LOAD(t0_); }
#pragma unroll 1
    for (int tl = bx; tl < 3072; tl += G, ++jn) {
        const int t = AT_TASK(jn);
        const int sub = t & 15, gi = (t >> 4) % 3, bh = t / 48, h = bh & 15, bl = bh >> 4;
        const int sh = 2 * gi, d = 1 << sh, r = sub & (d - 1), n = sub >> sh;
        const float ad = exp2f(-8.f * (float)(gi * 16 + h + 1) / 48.f) * (float)d;
        bf16* OG = gi == 0 ? OG0 : (gi == 1 ? OG1 : OG2);
        {
            const f32x4 kw0 = *(const f32x4*)(knw + gi * 64 + 8 * oct), kw1 = *(const f32x4*)(knw + gi * 64 + 8 * oct + 4);
#pragma unroll
            for (int jj = 0; jj < 4; ++jj) {
                const int key = (tid >> 3) + 64 * jj; const v4u kq = kr[jj];
                float kf[8] = {bflo(kq.x), bfhi(kq.x), bflo(kq.y), bfhi(kq.y), bflo(kq.z), bfhi(kq.z), bflo(kq.w), bfhi(kq.w)};
                float ss = 0.f;
#pragma unroll
                for (int e = 0; e < 8; ++e) ss += kf[e] * kf[e];
                ss += __shfl_xor(ss, 1); ss += __shfl_xor(ss, 2); ss += __shfl_xor(ss, 4);
                const float rs = rsqrtf(ss * (1.f / 64.f) + EPS);
                v4u ko; ko.x = pk2(kf[0] * rs * kw0[0], kf[1] * rs * kw0[1]); ko.y = pk2(kf[2] * rs * kw0[2], kf[3] * rs * kw0[3]);
                ko.z = pk2(kf[4] * rs * kw1[0], kf[5] * rs * kw1[1]); ko.w = pk2(kf[6] * rs * kw1[2], kf[7] * rs * kw1[3]);
                *(LAS v4u*)(Ks + key * 72 + 8 * oct) = ko;
                *(LAS v4u*)(Vs + key * 80 + 8 * oct) = vr[jj];
            }
        }
        const int qi = 16 * w + l16;
        const size_t qrow = (size_t)bl * SEQL + (size_t)(128 * n + qi) * d + r;
        bf16x8 qreg[2];
        {
            float qf[2][8]; float ss = 0.f;
#pragma unroll
            for (int ks = 0; ks < 2; ++ks) {
                const v4u qq = qr[ks];
                qf[ks][0] = bflo(qq.x); qf[ks][1] = bfhi(qq.x); qf[ks][2] = bflo(qq.y); qf[ks][3] = bfhi(qq.y); qf[ks][4] = bflo(qq.z); qf[ks][5] = bfhi(qq.z); qf[ks][6] = bflo(qq.w); qf[ks][7] = bfhi(qq.w);
#pragma unroll
                for (int e = 0; e < 8; ++e) ss += qf[ks][e] * qf[ks][e];
            }
            ss += __shfl_xor(ss, 16); ss += __shfl_xor(ss, 32);
            const float rs = rsqrtf(ss * (1.f / 64.f) + EPS) * 0.125f;
#pragma unroll
            for (int ks = 0; ks < 2; ++ks) {
                const f32x4 w0 = *(const f32x4*)(qnw + gi * 64 + 32 * ks + 8 * g4), w1 = *(const f32x4*)(qnw + gi * 64 + 32 * ks + 8 * g4 + 4);
                v4u tq; tq.x = pk2(qf[ks][0] * rs * w0[0], qf[ks][1] * rs * w0[1]); tq.y = pk2(qf[ks][2] * rs * w0[2], qf[ks][3] * rs * w0[3]);
                tq.z = pk2(qf[ks][4] * rs * w1[0], qf[ks][5] * rs * w1[1]); tq.w = pk2(qf[ks][6] * rs * w1[2], qf[ks][7] * rs * w1[3]);
                qreg[ks] = __builtin_bit_cast(bf16x8, tq);
            }
        }
        v4u gg[2];
#pragma unroll
        for (int j = 0; j < 2; ++j) gg[j] = *(const v4u*)(Ygate + qrow * 1024 + (size_t)h * 64 + 32 * j + 8 * g4);
        LBAR();
        if (tl + G < 3072) { const int tn_ = AT_TASK(jn + 1); AT_LOAD(tn_); }
        const int tlo = (n == 0) ? 8 : 0;
        f32x4 sc[9]; float mx = -3.0e38f;
#pragma unroll
        for (int t9 = 0; t9 < 9; ++t9) {
            const int T = w + t9;
            if (T >= tlo) {
                f32x4 a4 = (f32x4){0.f, 0.f, 0.f, 0.f};
#pragma unroll
                for (int ks = 0; ks < 2; ++ks) { const bf16x8 a = *(const LAS bf16x8*)(Ks + (16 * T + l16) * 72 + 32 * ks + 8 * g4); a4 = mfma16(a, qreg[ks], a4); }
#pragma unroll
                for (int rr = 0; rr < 4; ++rr) {
                    const int kj = 16 * T + 4 * g4 + rr; const int dist = 128 + qi - kj;
                    const bool valid = (dist >= 0) && (dist <= 128);
                    const float sv = valid ? (a4[rr] - ad * (float)dist) : -1e30f;
                    sc[t9][rr] = sv; mx = fmaxf(mx, sv);
                }
            } else sc[t9] = (f32x4){-1e30f, -1e30f, -1e30f, -1e30f};
        }
        mx = fmaxf(mx, __shfl_xor(mx, 16)); mx = fmaxf(mx, __shfl_xor(mx, 32));
        float sum = 0.f;
#pragma unroll
        for (int t9 = 0; t9 < 9; ++t9)
#pragma unroll
            for (int rr = 0; rr < 4; ++rr) { const float p = __expf(sc[t9][rr] - mx); sc[t9][rr] = p; sum += p; }
        sum += __shfl_xor(sum, 16); sum += __shfl_xor(sum, 32);
        const float lse = mx + __logf(sum), inv = 1.f / sum;
        f32x4 oacc[4];
#pragma unroll
        for (int dt = 0; dt < 4; ++dt) oacc[dt] = (f32x4){0.f, 0.f, 0.f, 0.f};
#pragma unroll
        for (int k2 = 0; k2 < 5; ++k2) {
            const int T0 = w + 2 * k2;
            if (T0 + 1 >= tlo) {
                v4u bpu; bpu.x = pk2(sc[2 * k2][0], sc[2 * k2][1]); bpu.y = pk2(sc[2 * k2][2], sc[2 * k2][3]);
                if (k2 < 4) { bpu.z = pk2(sc[(2 * k2 + 1) % 9][0], sc[(2 * k2 + 1) % 9][1]); bpu.w = pk2(sc[(2 * k2 + 1) % 9][2], sc[(2 * k2 + 1) % 9][3]); } else { bpu.z = 0u; bpu.w = 0u; }
                const bf16x8 bp = __builtin_bit_cast(bf16x8, bpu);
                const LAS bf16* vb = Vs + (16 * T0 + 4 * g4 + (l16 >> 2)) * 80 + 8 * (l16 & 3);
#pragma unroll
                for (int dt = 0; dt < 4; ++dt) {
                    const int co = 32 * (dt >> 1) + 4 * (dt & 1);
                    const v4i16_t lo = __builtin_amdgcn_ds_read_tr16_b64_v4i16((LAS v4i16_t*)(vb + co));
                    v4i16_t hi = (v4i16_t){0, 0, 0, 0};
                    if (k2 < 4) hi = __builtin_amdgcn_ds_read_tr16_b64_v4i16((LAS v4i16_t*)(vb + 16 * 80 + co));
                    oacc[dt] = mfma16((bf16x8){lo[0], lo[1], lo[2], lo[3], hi[0], hi[1], hi[2], hi[3]}, bp, oacc[dt]);
                }
            }
        }
#pragma unroll
        for (int j = 0; j < 2; ++j) {
            const size_t off = qrow * 1024 + (size_t)h * 64 + 32 * j + 8 * g4; const v4u g = gg[j]; const f32x4 e = oacc[2 * j], o = oacc[2 * j + 1];
            v4u y;
            y.x = pk2(e[0] * inv * bflo(g.x), e[1] * inv * bfhi(g.x)); y.y = pk2(e[2] * inv * bflo(g.y), e[3] * inv * bfhi(g.y));
            y.z = pk2(o[0] * inv * bflo(g.z), o[1] * inv * bfhi(g.z)); y.w = pk2(o[2] * inv * bflo(g.w), o[3] * inv * bfhi(g.w));
            *(v4u*)(OG + off) = y;
        }
        if (g4 == 0) LSE[((size_t)gi * 8192 + qrow) * 16 + h] = lse;
        LBAR();
    }
#undef AT_LOAD
#undef AT_TASK
}

constexpr int G_WA = 0;
constexpr int G_VT = 128 * 272;
__device__ __forceinline__ void gmlp_stage_w(LAS unsigned char* lds, int g, const float* ws) {
    int tid_l = threadIdx.x; asm volatile("" : "+v"(tid_l));
    const int tid = tid_l; LAS bf16* Wa = (LAS bf16*)(lds + G_WA);
    const int t = tid >> 2, sq = (tid & 3) * 32;
    const float* wrow = ws + ((size_t)g * 128 + t) * 128 + sq;
#pragma unroll
    for (int j = 0; j < 8; ++j) {
        const f32x4 v = *(const f32x4*)(wrow + 4 * j); const int s = sq + 4 * j;
        const float a0 = (s + 0 <= t) ? v[0] : 0.f, a1 = (s + 1 <= t) ? v[1] : 0.f, a2 = (s + 2 <= t) ? v[2] : 0.f, a3 = (s + 3 <= t) ? v[3] : 0.f;
        *(LAS v2u*)(Wa + t * 136 + s) = (v2u){pk2(a0, a1), pk2(a2, a3)};
    }
}
__device__ __forceinline__ void gmlp_unit(LAS unsigned char* lds, int unit, const bf16* U, const bf16* Vb, bf16* Y, const float* vs1, const float* vs2,
                                          const float* lnw, const float* lnb, const float* bs) {
    int tid_l = threadIdx.x; asm volatile("" : "+v"(tid_l));
    const int tid = tid_l, lane = tid & 63, w = __builtin_amdgcn_readfirstlane(tid >> 6), l16 = lane & 15, g4 = lane >> 4;
    LAS bf16* Wa = (LAS bf16*)(lds + G_WA); LAS bf16* Vt = (LAS bf16*)(lds + G_VT);
    const int g = unit & 7, bn = unit >> 3;
    const size_t m0 = (size_t)bn * 128; const int c0 = g * 128;
    const int t = 16 * w + l16;
    v4u uu[4], gg[4];
#pragma unroll
    for (int j = 0; j < 4; ++j) { const size_t off = (m0 + t) * 1024 + c0 + 32 * j + 8 * g4; uu[j] = *(const v4u*)(U + off); gg[j] = *(const v4u*)(Y + off); }
    {
        const int s = tid >> 2, cq = (tid & 3) * 32;
        const size_t row = m0 + s;
        const float mean = vs1[row] * (1.f / 1024.f); const float var = vs2[row] * (1.f / 1024.f) - mean * mean; const float rstd = rsqrtf(fmaxf(var, 0.f) + EPS);
#pragma unroll
        for (int j = 0; j < 4; ++j) {
            const int cc = cq + 8 * j;
            const v4u vr = *(const v4u*)(Vb + row * 1024 + c0 + cc);
            const f32x4 w0 = *(const f32x4*)(lnw + c0 + cc), w1 = *(const f32x4*)(lnw + c0 + cc + 4), b0 = *(const f32x4*)(lnb + c0 + cc), b1 = *(const f32x4*)(lnb + c0 + cc + 4);
            const float y8[8] = {(bflo(vr.x) - mean) * rstd * w0[0] + b0[0], (bfhi(vr.x) - mean) * rstd * w0[1] + b0[1], (bflo(vr.y) - mean) * rstd * w0[2] + b0[2], (bfhi(vr.y) - mean) * rstd * w0[3] + b0[3],
                                 (bflo(vr.z) - mean) * rstd * w1[0] + b1[0], (bfhi(vr.z) - mean) * rstd * w1[1] + b1[1], (bflo(vr.w) - mean) * rstd * w1[2] + b1[2], (bfhi(vr.w) - mean) * rstd * w1[3] + b1[3]};
            *(LAS v4u*)(Vt + s * 144 + cc) = pack8(y8);
        }
    }
    LBAR();
    bf16x8 bw[4];
#pragma unroll
    for (int ks = 0; ks < 4; ++ks) bw[ks] = *(const LAS bf16x8*)(Wa + (16 * w + l16) * 136 + 32 * ks + 8 * g4);
    const float bias = bs[g * 128 + t];
#pragma unroll
    for (int j = 0; j < 4; ++j) {
        const LAS bf16* vb = Vt + (8 * g4 + (l16 >> 2)) * 144 + 32 * j + 8 * (l16 & 3);
        f32x4 e4 = (f32x4){0.f, 0.f, 0.f, 0.f}, o4 = e4;
#pragma unroll
        for (int ks = 0; ks < 4; ++ks) {
            const v4u ae = tr_pair(vb + 32 * ks * 144, 4 * 144), ao = tr_pair(vb + 32 * ks * 144 + 4, 4 * 144);
            e4 = mfma16(__builtin_bit_cast(bf16x8, ae), bw[ks], e4); o4 = mfma16(__builtin_bit_cast(bf16x8, ao), bw[ks], o4);
        }
        const size_t off = (m0 + t) * 1024 + c0 + 32 * j + 8 * g4;
        const v4u u4 = uu[j], g4v = gg[j];
        v4u y;
        y.x = pk2(bflo(u4.x) * (e4[0] + bias) * bflo(g4v.x), bfhi(u4.x) * (e4[1] + bias) * bfhi(g4v.x)); y.y = pk2(bflo(u4.y) * (e4[2] + bias) * bflo(g4v.y), bfhi(u4.y) * (e4[3] + bias) * bfhi(g4v.y));
        y.z = pk2(bflo(u4.z) * (o4[0] + bias) * bflo(g4v.z), bfhi(u4.z) * (o4[1] + bias) * bfhi(g4v.z)); y.w = pk2(bflo(u4.w) * (o4[2] + bias) * bflo(g4v.w), bfhi(u4.w) * (o4[3] + bias) * bfhi(g4v.w));
        *(v4u*)(Y + off) = y;
    }
    LBAR();
}

struct Args {
    const float* x; const float* norm_w; const float* a_w_in; const float* a_lb; const float* a_onw; const float* a_w_out;
    const float* b_w_in; const float* b_qnw; const float* b_knw; const float* b_w_out;
    const float* c_w_in; const float* c_lnw; const float* c_lnb; const float* c_ws; const float* c_bs; const float* c_w_out;
    float* out; unsigned char* ws;
};

__global__ void __launch_bounds__(NTHREADS, 2) fwd_megakernel(Args A) {
    extern __shared__ __attribute__((aligned(16))) unsigned char lds_raw[];
    LAS unsigned char* lds = (LAS unsigned char*)lds_raw;
    cg::grid_group grid = cg::this_grid();
    const int tid = threadIdx.x, lane = tid & 63, wave = __builtin_amdgcn_readfirstlane(tid >> 6);
    const int G = gridDim.x, bx = blockIdx.x;
    const int gw = bx * NWAVES + wave, NGW = G * NWAVES;
    unsigned char* ws = A.ws;
    float* ssq = (float*)(ws + WS_CTL);
    float* vs1 = ssq + 4 * MROWS; float* vs2 = vs1 + MROWS;
    bf16* WIN = (bf16*)(ws + WS_WIN); bf16* WOUT = (bf16*)(ws + WS_WOUT); bf16* XB = (bf16*)(ws + WS_XB); bf16* Y = (bf16*)(ws + WS_Y);
    bf16* PROJ = (bf16*)(ws + WS_PROJ); bf16* EXTRA = (bf16*)(ws + WS_EXTRA); float* LSE = (float*)(ws + WS_LSE);
    constexpr size_t PLANE = (size_t)MROWS * DM;
    bf16* W_BO = (bf16*)A.out + (size_t)20 * MiB; bf16* W_CI = (bf16*)A.out + (size_t)21 * MiB; bf16* W_CO = (bf16*)A.out + (size_t)24 * MiB; bf16* W_A1 = (bf16*)A.out + (size_t)25 * MiB;

    volatile LAS unsigned* xst = (volatile LAS unsigned*)(lds + LDS_BYTES - 64);
    if (tid < 16) xst[tid] = 0u;
    __syncthreads();
    const XcdBarrier xbar = xcd_barrier_post((unsigned*)(ws + WS_BAR), xst);
#define GSYNC() xcd_barrier(xbar)

    convert_weight(A.a_w_in, 1024, 4096, WIN, A.norm_w, lds, gw, NGW);
    convert_weight(A.a_w_out, 1024, 1024, WOUT, nullptr, lds, gw, NGW);
    for (int m = 2 * gw; m < MROWS; m += 2 * NGW) {
        const f32x4* xr = (const f32x4*)(A.x + (size_t)m * DM) + 2 * lane; v4u* o16 = (v4u*)(XB + (size_t)m * DM) + lane; float s0 = 0.f, s1 = 0.f;
        f32x4 va[4], vb[4];
#pragma unroll
        for (int j = 0; j < 2; ++j) { va[2 * j] = xr[128 * j]; va[2 * j + 1] = xr[128 * j + 1]; vb[2 * j] = xr[256 + 128 * j]; vb[2 * j + 1] = xr[256 + 128 * j + 1]; }
#pragma unroll
        for (int j = 0; j < 4; ++j) { s0 += (va[j][0] * va[j][0] + va[j][1] * va[j][1]) + (va[j][2] * va[j][2] + va[j][3] * va[j][3]); s1 += (vb[j][0] * vb[j][0] + vb[j][1] * vb[j][1]) + (vb[j][2] * vb[j][2] + vb[j][3] * vb[j][3]); }
#pragma unroll
        for (int j = 0; j < 2; ++j) {
            o16[64 * j] = (v4u){pk2(va[2 * j][0], va[2 * j][1]), pk2(va[2 * j][2], va[2 * j][3]), pk2(va[2 * j + 1][0], va[2 * j + 1][1]), pk2(va[2 * j + 1][2], va[2 * j + 1][3])};
            o16[128 + 64 * j] = (v4u){pk2(vb[2 * j][0], vb[2 * j][1]), pk2(vb[2 * j][2], vb[2 * j][3]), pk2(vb[2 * j + 1][0], vb[2 * j + 1][1]), pk2(vb[2 * j + 1][2], vb[2 * j + 1][3])};
        }
#pragma unroll
        for (int o = 1; o < 64; o <<= 1) { s0 += __shfl_xor(s0, o); s1 += __shfl_xor(s1, o); }
        if (lane == 0) { ssq[m] = s0; ssq[m + 1] = s1; }
    }
    for (int i = bx * NTHREADS + tid; i < 5 * MROWS; i += G * NTHREADS) ssq[MROWS + i] = 0.f;
    if (A.ws == nullptr) grid.sync();
    GSYNC();

#pragma unroll 1
    for (int rep = 0; rep < 2; ++rep) {
        const int layer = rep * 3, idx = rep;
        if (rep == 1) {
#pragma unroll 1
            for (int hb = 0; hb < 2; ++hb) {
                const int row_base = hb * 8192;
                {
                    pg8::Gemm g{XB + (size_t)row_base * DM, WIN, 8192, 10240, 1024}; pg8::StaticOrder S; S.init(8192, 10240, G, bx);
                    EpiIn<1> E{ssq + 1 * MROWS, row_base, PROJ, nullptr, nullptr, nullptr, Y, nullptr, 0, nullptr, nullptr};
                    pg8::gemm_phase<EpiIn<1>, pg8::StaticOrder, true, true>(lds, g, S, E);
                }
                GSYNC();
                bf16* OG0 = (bf16*)A.out; bf16* OG1 = (bf16*)A.out + (size_t)8192 * DM; bf16* OG2 = EXTRA;
                {
                    __syncthreads();
                    attn_phase(lds, PROJ, Y + (size_t)row_base * DM, OG0, OG1, OG2, LSE, A.b_qnw, A.b_knw, bx, G);
                }
                GSYNC();
                for (int i = bx * NTHREADS + tid; i < 8192 * 128; i += G * NTHREADS) {
                    const int row = i >> 7, o8 = i & 127, h = o8 >> 3;
                    const float l0 = LSE[((size_t)0 * 8192 + row) * 16 + h], l1 = LSE[((size_t)1 * 8192 + row) * 16 + h], l2 = LSE[((size_t)2 * 8192 + row) * 16 + h];
                    const float mx = fmaxf(l0, fmaxf(l1, l2)); const float e0 = __expf(l0 - mx), e1 = __expf(l1 - mx), e2 = __expf(l2 - mx); const float inv = 1.f / (e0 + e1 + e2);
                    const float w0 = e0 * inv, w1 = e1 * inv, w2 = e2 * inv;
                    const size_t off = (size_t)row * DM + 8 * o8;
                    const v4u a = *(const v4u*)(OG0 + off), b = *(const v4u*)(OG1 + off), c = *(const v4u*)(OG2 + off);
                    v4u o;
                    o.x = pk2(w0 * bflo(a.x) + w1 * bflo(b.x) + w2 * bflo(c.x), w0 * bfhi(a.x) + w1 * bfhi(b.x) + w2 * bfhi(c.x));
                    o.y = pk2(w0 * bflo(a.y) + w1 * bflo(b.y) + w2 * bflo(c.y), w0 * bfhi(a.y) + w1 * bfhi(b.y) + w2 * bfhi(c.y));
                    o.z = pk2(w0 * bflo(a.z) + w1 * bflo(b.z) + w2 * bflo(c.z), w0 * bfhi(a.z) + w1 * bfhi(b.z) + w2 * bfhi(c.z));
                    o.w = pk2(w0 * bflo(a.w) + w1 * bflo(b.w) + w2 * bflo(c.w), w0 * bfhi(a.w) + w1 * bfhi(b.w) + w2 * bfhi(c.w));
                    *(v4u*)(Y + (size_t)row_base * DM + off) = o;
                }
                GSYNC();
            }
            {
                pg8::Gemm g{Y, W_BO, MROWS, 1024, 1024}; pg8::StaticOrder S; S.init(MROWS, 1024, G, bx);
                EpiOut E{nullptr, nullptr, XB, ssq + 2 * MROWS};
                pg8::gemm_phase<EpiOut, pg8::StaticOrder, true, true>(lds, g, S, E);
            }
            if (DBG_STOP == 2) return;
            GSYNC();
            {
                pg8::Gemm g{XB, W_CI, MROWS, 3072, 1024}; pg8::StaticOrder S; S.init(MROWS, 3072, G, bx);
                EpiIn<2> E{ssq + 2 * MROWS, 0, PROJ, PROJ + PLANE, nullptr, nullptr, Y, nullptr, 0, vs1, vs2};
                pg8::gemm_phase<EpiIn<2>, pg8::StaticOrder, true, true>(lds, g, S, E);
            }
            GSYNC();
            {
                __syncthreads();
                if ((G & 7) == 0 && bx < 1024) gmlp_stage_w(lds, bx & 7, A.c_ws);
                for (int u = bx; u < 1024; u += G) { if ((G & 7) != 0) { gmlp_stage_w(lds, u & 7, A.c_ws); } gmlp_unit(lds, u, PROJ, PROJ + PLANE, Y, vs1, vs2, A.c_lnw, A.c_lnb, A.c_bs); }
            }
            GSYNC();
            {
                pg8::Gemm g{Y, W_CO, MROWS, 1024, 1024}; pg8::StaticOrder S; S.init(MROWS, 1024, G, bx);
                EpiOut E{nullptr, nullptr, XB, ssq + 3 * MROWS};
                pg8::gemm_phase<EpiOut, pg8::StaticOrder, true, true>(lds, g, S, E);
            }
            GSYNC();
        }
        bf16* Qb = PROJ; bf16* KKb = PROJ + PLANE; bf16* Vb = PROJ + 2 * PLANE; float* LOGF = (float*)(PROJ + 3 * PLANE);
        {
            pg8::Gemm g{XB, rep == 0 ? WIN : W_A1, MROWS, 4096, 1024}; pg8::StaticOrder S; S.init(MROWS, 4096, G, bx);
            EpiIn<0> E{ssq + (size_t)layer * MROWS, 0, Qb, KKb, Vb, LOGF, Y, A.a_lb, idx, nullptr, nullptr};
            pg8::gemm_phase<EpiIn<0>, pg8::StaticOrder, true, true>(lds, g, S, E);
            if (rep == 1) convert_weight(A.a_w_out + (size_t)1024 * 1024, 1024, 1024, WOUT, nullptr, lds, gw, NGW);
        }
        GSYNC();
        bf16* PBUF = (bf16*)A.out; float* DBUF = (float*)((bf16*)A.out + (size_t)2048 * 4096);
        hgrn_prepass(lds, Qb, KKb, LOGF, PBUF, DBUF, bx, G);
        GSYNC();
        {
            if (rep == 0) {
                const int nconv = G - 64; const int gwc = nconv > 0 ? (bx >= 64 ? (bx - 64) * NWAVES + wave : -1) : gw; const int ngwc = nconv > 0 ? nconv * NWAVES : NGW;
                convert_weight(A.b_w_in, 1024, 10240, WIN, A.norm_w + 1 * DM, lds, gwc, ngwc);
                convert_weight(A.b_w_out, 1024, 1024, W_BO, nullptr, lds, gwc, ngwc);
                convert_weight(A.c_w_in, 1024, 3072, W_CI, A.norm_w + 2 * DM, lds, gwc, ngwc);
                convert_weight(A.c_w_out, 1024, 1024, W_CO, nullptr, lds, gwc, ngwc);
                convert_weight(A.a_w_in + (size_t)1024 * 4096, 1024, 4096, W_A1, A.norm_w + 3 * DM, lds, gwc, ngwc);
            }
            __syncthreads();
            for (int u = bx; u < 64; u += G) { hgrn_unit(lds, u >> 3, u & 7, Qb, KKb, Vb, PBUF, DBUF, Y, A.a_onw + idx * 128); __syncthreads(); }
        }
        GSYNC();
        {
            pg8::Gemm g{Y, WOUT, MROWS, 1024, 1024}; pg8::StaticOrder S; S.init(MROWS, 1024, G, bx);
            EpiOut E{rep == 0 ? A.x : nullptr, rep == 0 ? nullptr : A.out, XB, rep == 0 ? ssq + 1 * MROWS : nullptr};
            pg8::gemm_phase<EpiOut, pg8::StaticOrder, true, true>(lds, g, S, E);
        }
        if (DBG_STOP == 1) return;
        if (rep == 0) GSYNC();
    }
#undef GSYNC
}

extern "C" void kernel_launch(void* const* d_in, const int* in_sizes, int n_in, void* d_out, int out_size, void* d_ws, size_t ws_size, hipStream_t stream) {
    static int grid = 0;
    if (grid == 0) {
        if (n_in != 16 || in_sizes[0] != MROWS * DM || out_size != MROWS * DM || ws_size < WS_END) { fprintf(stderr, "kernel_launch: unexpected shapes / workspace (%d inputs, ws %zu)\n", n_in, ws_size); grid = -1; return; }
        int dev = 0, cus = 0, per_cu = 0;
        if (hipGetDevice(&dev) != hipSuccess || hipDeviceGetAttribute(&cus, hipDeviceAttributeMultiprocessorCount, dev) != hipSuccess) { grid = -1; return; }
        if (hipFuncSetAttribute((const void*)fwd_megakernel, hipFuncAttributeMaxDynamicSharedMemorySize, LDS_BYTES) != hipSuccess) { fprintf(stderr, "kernel_launch: hipFuncSetAttribute failed\n"); grid = -1; return; }
        if (hipOccupancyMaxActiveBlocksPerMultiprocessor(&per_cu, (const void*)fwd_megakernel, NTHREADS, LDS_BYTES) != hipSuccess || per_cu < 1) { fprintf(stderr, "kernel_launch: occupancy query says %d\n", per_cu); per_cu = 1; }
        (void)hipGetLastError();
        grid = cus;
    }
    if (grid < 0) return;
    Args a{};
    a.x = (const float*)d_in[0]; a.norm_w = (const float*)d_in[1]; a.a_w_in = (const float*)d_in[2]; a.a_lb = (const float*)d_in[3]; a.a_onw = (const float*)d_in[4]; a.a_w_out = (const float*)d_in[5];
    a.b_w_in = (const float*)d_in[6]; a.b_qnw = (const float*)d_in[7]; a.b_knw = (const float*)d_in[8]; a.b_w_out = (const float*)d_in[9];
    a.c_w_in = (const float*)d_in[10]; a.c_lnw = (const float*)d_in[11]; a.c_lnb = (const float*)d_in[12]; a.c_ws = (const float*)d_in[13]; a.c_bs = (const float*)d_in[14]; a.c_w_out = (const float*)d_in[15];
    a.out = (float*)d_out; a.ws = (unsigned char*)d_ws;
    if (hipMemsetAsync((char*)d_ws + WS_BAR, 0, 16384, stream) != hipSuccess) { fprintf(stderr, "kernel_launch: memset failed\n"); return; }
    void* args[] = {&a};
    const hipError_t e = hipLaunchCooperativeKernel((const void*)fwd_megakernel, dim3(grid), dim3(NTHREADS), args, LDS_BYTES, stream);
    if (e != hipSuccess) fprintf(stderr, "kernel_launch: cooperative launch failed: %s (grid %d)\n", hipGetErrorString(e), grid);
}
```
